# Optimizing an MI355X kernel written in HIP

```python
import jax, jax.numpy as jnp
from jax import lax
import numpy as np

D_MODEL = 2048
BATCH = 16
SEQ = 2048
DEPTH = 2

CHUNK = 64
N_MIXERS = 2
EPS = 1e-6

HGRN_HEADS = 16
HGRN_DK = 128
HGRN_DV = D_MODEL // HGRN_HEADS
HGRN_KEY = HGRN_HEADS * HGRN_DK
HGRN_VAL = HGRN_HEADS * HGRN_DV

SGU_BLOCK = 128
SGU_GROUPS = 16
SGU_WIDTH = D_MODEL
SGU_GROUP_DIM = SGU_WIDTH // SGU_GROUPS

D_FF = 5632
N_EXPERTS = 8
TOP_K = 2
D_FF_EXPERT = 7168

kernel_name = "hybrid_hgrn2_gmlp_moe_trunk"


def rms_norm(x, g):
    xf = x.astype(jnp.float32)
    y = xf * lax.rsqrt(jnp.mean(xf * xf, axis=-1, keepdims=True) + EPS)
    return (y * g.astype(jnp.float32)).astype(x.dtype)


def layer_norm(x, g, b):
    xf = x.astype(jnp.float32)
    mu = jnp.mean(xf, axis=-1, keepdims=True)
    xc = xf - mu
    y = xc * lax.rsqrt(jnp.mean(xc * xc, axis=-1, keepdims=True) + EPS)
    return (y * g.astype(jnp.float32) + b.astype(jnp.float32)).astype(x.dtype)


def hgrn2_chunk_scan(q, k, v, g):
    B, T, H, DK = q.shape
    DV = v.shape[-1]
    n = T // CHUNK

    def to_chunks(a):
        return a.reshape(B, n, CHUNK, H, a.shape[-1]).transpose(1, 0, 3, 2, 4)

    q, k, v, g = to_chunks(q), to_chunks(k), to_chunks(v), to_chunks(g)
    b = jnp.cumsum(g, axis=-2)
    b_mid = b[..., CHUNK // 2 - 1:CHUNK // 2, :]
    b_last = b[..., -1:, :]
    q_intra = q * jnp.exp(b - b_mid)
    k_intra = k * jnp.exp(b_mid - b)
    q_inter = q * jnp.exp(b)
    k_state = k * jnp.exp(b_last - b)
    decay = jnp.exp(b_last[..., 0, :])
    causal = jnp.tril(jnp.ones((CHUNK, CHUNK), dtype=bool))

    def step(S, xs):
        qi, ki, qe, ks, vc, dc = xs
        scores = jnp.where(causal, jnp.einsum('bhtk,bhsk->bhts', qi, ki), 0.0)
        o = (jnp.einsum('bhts,bhsv->bhtv', scores, vc)
             + jnp.einsum('bhtk,bhkv->bhtv', qe, S))
        S = dc[..., None] * S + jnp.einsum('bhsk,bhsv->bhkv', ks, vc)
        return S, o

    S0 = jnp.zeros((B, H, DK, DV), jnp.float32)
    _, o = lax.scan(step, S0, (q_intra, k_intra, q_inter, k_state, v, decay))
    return o.transpose(1, 0, 3, 2, 4).reshape(B, T, H, DV)


def hgrn2_mixer(h, w_in, lb, norm_g, w_out):
    B, T, _ = h.shape
    proj = h @ w_in
    q, f, i, gate = jnp.split(proj, [HGRN_KEY, 2 * HGRN_KEY, 2 * HGRN_KEY + HGRN_VAL], axis=-1)
    q = jax.nn.silu(q.astype(jnp.float32))
    f = f.astype(jnp.float32)
    forget = lb + (1.0 - lb) * jax.nn.sigmoid(f)
    log_f = jnp.log(forget)
    k = (1.0 - lb) * jax.nn.sigmoid(-f)
    o = hgrn2_chunk_scan(q.reshape(B, T, HGRN_HEADS, HGRN_DK),
                         k.reshape(B, T, HGRN_HEADS, HGRN_DK),
                         i.astype(jnp.float32).reshape(B, T, HGRN_HEADS, HGRN_DV),
                         log_f.reshape(B, T, HGRN_HEADS, HGRN_DK))
    o = o * lax.rsqrt(jnp.mean(o * o, axis=-1, keepdims=True) + EPS)
    o = o.reshape(B, T, HGRN_VAL) * norm_g.astype(jnp.float32) * jax.nn.silu(gate.astype(jnp.float32))
    return o.astype(h.dtype) @ w_out


def sgu_mixer(h, w_in, ln_g, ln_b, w_s, b_s, w_out):
    B, T, _ = h.shape
    uv = jax.nn.gelu(h @ w_in, approximate=False)
    u, v = jnp.split(uv, 2, axis=-1)
    v = layer_norm(v, ln_g, ln_b)
    n = T // SGU_BLOCK
    v = v.reshape(B, n, SGU_BLOCK, SGU_GROUPS, SGU_GROUP_DIM)
    pos_chunk = jnp.arange(SGU_BLOCK) // CHUNK
    mask = pos_chunk[:, None] >= pos_chunk[None, :]
    ws = jnp.where(mask[None], w_s, 0.0).astype(v.dtype)
    v = jnp.einsum('gts,bnsgc->bntgc', ws, v) + b_s.T[:, :, None].astype(v.dtype)
    return (u * v.reshape(B, T, SGU_WIDTH)) @ w_out


def swiglu(h, w_gate, w_up, w_down):
    return (jax.nn.silu(h @ w_gate) * (h @ w_up)) @ w_down


def moe_swiglu(h, w_router, w_gate, w_up, w_down):
    logits = (h @ w_router).astype(jnp.float32)
    top_val, top_idx = lax.top_k(logits, TOP_K)
    top_w = jax.nn.softmax(top_val, axis=-1)
    gates = jnp.sum(jax.nn.one_hot(top_idx, N_EXPERTS, dtype=jnp.float32) * top_w[..., None], axis=-2)
    gates = gates.astype(h.dtype)
    y = jnp.zeros_like(h)
    for e in range(N_EXPERTS):
        y = y + gates[..., e:e + 1] * swiglu(h, w_gate[e], w_up[e], w_down[e])
    return y


def setup_inputs(seed: int = 0) -> dict:
    key = jax.random.key(seed)
    ks = jax.random.split(key, 24)
    f32 = jnp.float32
    D = D_MODEL

    def nrm(k, shape, scale):
        return jax.random.normal(k, shape, f32) * scale

    def gain(k, n):
        return 1.0 + 0.05 * jax.random.normal(k, (n,), f32)

    return {
        "x": nrm(ks[0], (BATCH, SEQ, D), 1.0),
        "lb_logits": nrm(ks[1], (DEPTH + 1, HGRN_KEY), 0.1),
        "l0_norm_mix": gain(ks[2], D),
        "l0_hgrn_w_in": nrm(ks[3], (D, 2 * HGRN_KEY + 2 * HGRN_VAL), D ** -0.5),
        "l0_hgrn_norm": gain(ks[4], HGRN_VAL),
        "l0_hgrn_w_out": nrm(ks[5], (HGRN_VAL, D), HGRN_VAL ** -0.5),
        "l0_norm_ffn": gain(ks[6], D),
        "l0_ffn_w_gate": nrm(ks[7], (D, D_FF), D ** -0.5),
        "l0_ffn_w_up": nrm(ks[8], (D, D_FF), D ** -0.5),
        "l0_ffn_w_down": nrm(ks[9], (D_FF, D), D_FF ** -0.5),
        "l1_norm_mix": gain(ks[10], D),
        "l1_sgu_w_in": nrm(ks[11], (D, 2 * SGU_WIDTH), D ** -0.5),
        "l1_sgu_ln_g": gain(ks[12], SGU_WIDTH),
        "l1_sgu_ln_b": nrm(ks[13], (SGU_WIDTH,), 0.02),
        "l1_sgu_w_s": nrm(ks[14], (SGU_GROUPS, SGU_BLOCK, SGU_BLOCK), SGU_BLOCK ** -0.5),
        "l1_sgu_b_s": 1.0 + nrm(ks[15], (SGU_GROUPS, SGU_BLOCK), 0.1),
        "l1_sgu_w_out": nrm(ks[16], (SGU_WIDTH, D), SGU_WIDTH ** -0.5),
        "l1_norm_ffn": gain(ks[17], D),
        "l1_moe_w_router": nrm(ks[18], (D, N_EXPERTS), D ** -0.5),
        "l1_moe_w_gate": nrm(ks[19], (N_EXPERTS, D, D_FF_EXPERT), D ** -0.5),
        "l1_moe_w_up": nrm(ks[20], (N_EXPERTS, D, D_FF_EXPERT), D ** -0.5),
        "l1_moe_w_down": nrm(ks[21], (N_EXPERTS, D_FF_EXPERT, D), D_FF_EXPERT ** -0.5),
        "final_norm": gain(ks[22], D),
    }


def reference(x, lb_logits,
              l0_norm_mix, l0_hgrn_w_in, l0_hgrn_norm, l0_hgrn_w_out,
              l0_norm_ffn, l0_ffn_w_gate, l0_ffn_w_up, l0_ffn_w_down,
              l1_norm_mix, l1_sgu_w_in, l1_sgu_ln_g, l1_sgu_ln_b, l1_sgu_w_s, l1_sgu_b_s, l1_sgu_w_out,
              l1_norm_ffn, l1_moe_w_router, l1_moe_w_gate, l1_moe_w_up, l1_moe_w_down,
              final_norm):
    lb_all = jnp.cumsum(jax.nn.softmax(lb_logits.astype(jnp.float32), axis=0), axis=0)

    mixers = [
        lambda h: hgrn2_mixer(h, l0_hgrn_w_in, lb_all[0], l0_hgrn_norm, l0_hgrn_w_out),
        lambda h: sgu_mixer(h, l1_sgu_w_in, l1_sgu_ln_g, l1_sgu_ln_b, l1_sgu_w_s, l1_sgu_b_s, l1_sgu_w_out),
    ]
    ffns = [
        lambda h: swiglu(h, l0_ffn_w_gate, l0_ffn_w_up, l0_ffn_w_down),
        lambda h: moe_swiglu(h, l1_moe_w_router, l1_moe_w_gate, l1_moe_w_up, l1_moe_w_down),
    ]
    norm_mix = [l0_norm_mix, l1_norm_mix]
    norm_ffn = [l0_norm_ffn, l1_norm_ffn]

    for i in range(DEPTH):
        x = x + mixers[i](rms_norm(x, norm_mix[i]))
        x = x + ffns[i](rms_norm(x, norm_ffn[i]))
    return rms_norm(x, final_norm)
```

```cpp
#include <hip/hip_runtime.h>
#include <cstdio>
#include <cstdint>

#ifndef MK_PER_PHASE
#define MK_PER_PHASE 0
#endif

#ifndef KF_DEFAULT
#define KF_DEFAULT false
#endif
#ifndef KF_SWIGLU
#define KF_SWIGLU true
#endif
#ifndef KF_SGU
#define KF_SGU true
#endif
#ifndef ASM_STAGE
#define ASM_STAGE true
#endif
namespace pg8 {
#define PG8_LAS __attribute__((address_space(3)))
typedef unsigned short bf16_t;
typedef short bf16x8 __attribute__((ext_vector_type(8)));
typedef float f32x4 __attribute__((ext_vector_type(4)));
typedef float f32x2 __attribute__((ext_vector_type(2)));
typedef unsigned u32x4 __attribute__((ext_vector_type(4)));
typedef unsigned u32x2 __attribute__((ext_vector_type(2)));
typedef int i32x4 __attribute__((ext_vector_type(4)));
typedef int i32x8 __attribute__((ext_vector_type(8)));
__device__ __forceinline__ i32x8 cat8(bf16x8 a, bf16x8 b) { const i32x4 x = __builtin_bit_cast(i32x4, a), y = __builtin_bit_cast(i32x4, b); return __builtin_shufflevector(x, y, 0, 1, 2, 3, 4, 5, 6, 7); }
template <int OFF> __device__ __forceinline__ void glds16_s(const void* sbase, unsigned voff, unsigned lds_w) {
    const unsigned long long gb = (unsigned long long)sbase;
    const unsigned lo = __builtin_amdgcn_readfirstlane((unsigned)gb), hi = __builtin_amdgcn_readfirstlane((unsigned)(gb >> 32));
    const unsigned long long sb = ((unsigned long long)hi << 32) | lo; unsigned keep;
    asm volatile("s_mov_b32 %0, m0\n\ts_add_i32 m0, %3, %4\n\ts_nop 0\n\tglobal_load_lds_dwordx4 %1, %2\n\ts_mov_b32 m0, %0" : "=&s"(keep) : "v"(voff), "s"(sb), "s"(lds_w), "i"(OFF) : "memory", "scc");
}
__device__ __forceinline__ unsigned pk4_fp8(float a, float b, float c, float d) {
    a = __builtin_amdgcn_fmed3f(a, -448.f, 448.f); b = __builtin_amdgcn_fmed3f(b, -448.f, 448.f); c = __builtin_amdgcn_fmed3f(c, -448.f, 448.f); d = __builtin_amdgcn_fmed3f(d, -448.f, 448.f);
    int w = __builtin_amdgcn_cvt_pk_fp8_f32(a, b, 0, false); w = __builtin_amdgcn_cvt_pk_fp8_f32(c, d, w, true); return (unsigned)w; }
__device__ __forceinline__ unsigned pk4_i8(float a, float b, float c, float d) {
    a = __builtin_amdgcn_fmed3f(a, -127.f, 127.f) + 12582912.0f; b = __builtin_amdgcn_fmed3f(b, -127.f, 127.f) + 12582912.0f; c = __builtin_amdgcn_fmed3f(c, -127.f, 127.f) + 12582912.0f; d = __builtin_amdgcn_fmed3f(d, -127.f, 127.f) + 12582912.0f;
    const unsigned p01 = __builtin_amdgcn_perm(__builtin_bit_cast(unsigned, b), __builtin_bit_cast(unsigned, a), 0x0c0c0400u), p23 = __builtin_amdgcn_perm(__builtin_bit_cast(unsigned, d), __builtin_bit_cast(unsigned, c), 0x0c0c0400u);
    return __builtin_amdgcn_perm(p23, p01, 0x05040100u); }
constexpr int BM = 256, BK = 64, HALF = 128, HTB = HALF * BK * 2  , STAGE_BYTES = 8 * HTB, NXCD = 8, WGM = 8;

__host__ __device__ __forceinline__ int lds_byte(int r, int c) { const int st = (r >> 4) * 2 + (c >> 5), rr = r & 15, cc = c & 31, ob = rr * 64 + cc * 2; return st * 1024 + (ob ^ (((ob >> 9) & 1) << 5)); }
__host__ __device__ __forceinline__ void stage_rc(int b, int& R, int& C) { const int st = b / 1024, sb = b % 1024, swz = sb ^ (((sb >> 9) & 1) << 5); R = (st >> 1) * 16 + swz / 64; C = (st & 1) * 32 + (swz % 64) / 2; }
__host__ __device__ __forceinline__ int perm32(int rho) { const int n = rho >> 4, i = rho & 15; return 8 * (i >> 2) + 4 * n + (i & 3); }

struct Unit { int pm, pn, e; };
struct Gemm { const bf16_t* A; const bf16_t* Bt; int M, N, K; size_t estride; };

struct StaticOrder {
    int nM, nN, nwg, G, c;
    __host__ __device__ void init(int M, int N, int G_, int c_) { nM = M / BM; nN = N / BM; nwg = nM * nN; G = G_; c = c_; }
    __host__ __device__ bool next(int i, Unit& u) const {
        const long L = (long)i * G + c; if (L >= nwg) return false;
        int wgid = (int)L; { const int q = nwg / NXCD, r = nwg % NXCD, xcd = wgid % NXCD, off = wgid / NXCD; wgid = (xcd < r ? xcd * (q + 1) : r * (q + 1) + (xcd - r) * q) + off; }
        const int nig = WGM * nN, gid = wgid / nig, fm = gid * WGM, gsz = (nM - fm) < WGM ? (nM - fm) : WGM;
        u.pm = fm + ((wgid % nig) % gsz); u.pn = (wgid % nig) / gsz; u.e = 0; return true;
    }
    __device__ __forceinline__ void a_ready(const Unit&) const {}
    __device__ __forceinline__ void done(const Unit&) const {}
};
struct ConstOrder {
    int nwg, G, c;
    __device__ void init(int M, int N, int G_, int c_) { nwg = (M / BM) * (N / BM); G = G_; c = c_; }
    __device__ bool next(int i, Unit& u) const { const long L = (long)i * G + c; if (L >= nwg) return false; u.pm = 0; u.pn = 0; u.e = 0; return true; }
    __device__ __forceinline__ void a_ready(const Unit&) const {}
    __device__ __forceinline__ void done(const Unit&) const {}
};
struct MoeOrder {
    int nM, nN, nwg, G, c; const int* panel_e;
    __device__ void init(int nM_, int nN_, int G_, int c_, const int* pe) { nM = nM_; nN = nN_; nwg = nM * nN; G = G_; c = c_; panel_e = pe; }
    __device__ bool next(int i, Unit& u) const {
        const long L = (long)i * G + c; if (L >= nwg) return false;
        int wgid = (int)L; { const int q = nwg / NXCD, r = nwg % NXCD, xcd = wgid % NXCD, off = wgid / NXCD; wgid = (xcd < r ? xcd * (q + 1) : r * (q + 1) + (xcd - r) * q) + off; }
        const int nig = WGM * nN, gid = wgid / nig, fm = gid * WGM, gsz = (nM - fm) < WGM ? (nM - fm) : WGM;
        u.pm = fm + ((wgid % nig) % gsz); u.pn = (wgid % nig) / gsz; u.e = __builtin_amdgcn_readfirstlane(panel_e[u.pm]); return true;
    }
    __device__ __forceinline__ void a_ready(const Unit&) const {}
    __device__ __forceinline__ void done(const Unit&) const {}
};

__device__ __forceinline__ unsigned cvt_pk_bf16(float lo, float hi) { unsigned r; asm volatile("v_cvt_pk_bf16_f32 %0, %1, %2" : "=v"(r) : "v"(lo), "v"(hi)); return r; }
__device__ __forceinline__ f32x2 gelu_pk(f32x2 v) {
    const f32x2 av = __builtin_elementwise_abs(v), d = av * 0.2316418882f + 1.0f;
    f32x2 t; t.x = __builtin_amdgcn_rcpf(d.x); t.y = __builtin_amdgcn_rcpf(d.y);
    f32x2 q = t * 0.5307027145f + (-0.7265760135f); q = q * t + 0.7107068705f; q = q * t + (-0.142248368f); q = q * t + 0.127414796f; q = q * t;
    const f32x2 s = (v * v) * (-0.72134752044f);
    f32x2 e; e.x = __builtin_amdgcn_exp2f(s.x); e.y = __builtin_amdgcn_exp2f(s.y);
    const f32x2 m = av * (q * e);
    f32x2 o; o.x = fmaxf(v.x, 0.f) - m.x; o.y = fmaxf(v.y, 0.f) - m.y; return o;
}
__device__ __forceinline__ float fsilu(float x) { return x * __builtin_amdgcn_rcpf(1.f + __builtin_amdgcn_exp2f(-1.44269504f * x)); }
constexpr float INV_D = 1.0f / 2048.0f, RMS_EPS = 1e-6f;
constexpr float FX_SCALE = 16777216.0f, FX_INV = 1.0f / 16777216.0f;
typedef unsigned long long u64;
__device__ __forceinline__ void fx_add(u64* p, float v) { atomicAdd(p, (u64)(long long)__float2ll_rn(v * FX_SCALE)); }
__device__ __forceinline__ float fx_get(const u64* p) { return (float)(long long)(*p) * FX_INV; }
constexpr int RSL_OFF = 131072;
__device__ __forceinline__ void rs_prefetch(const u64* rss, int pm, PG8_LAS unsigned char* lds, int wid, int slot) {
    const int lane = (int)__builtin_amdgcn_mbcnt_hi(~0u, __builtin_amdgcn_mbcnt_lo(~0u, 0u));
    const unsigned dst = __builtin_amdgcn_readfirstlane((unsigned)(size_t)lds + (unsigned)(RSL_OFF + slot * 2048 + (wid & 1) * 1024));
    glds16_s<0>((const void*)(rss + (size_t)pm * 256), (unsigned)((wid & 1) * 1024 + lane * 16), dst);
}
__device__ __forceinline__ float fx_get_lds(const PG8_LAS u64* p) { return (float)(long long)(*p) * FX_INV; }
__device__ __forceinline__ float fx_rs_lds(const PG8_LAS u64* p, float sc) { const u64 v = *p;
    const float m = __builtin_fmaf((float)(unsigned)(v >> 32), 4294967296.0f * FX_INV * INV_D, __builtin_fmaf((float)(unsigned)v, FX_INV * INV_D, RMS_EPS)); return sc * __builtin_amdgcn_rsqf(m); }

struct EpiHgrnIn {
    static constexpr bool PERM = true, AFTER_DRAIN = false, RSP = false, KEEPF = KF_DEFAULT;
    float sc; const float* lb; bf16_t *Q, *Gl, *Iv, *Gt;
    __device__ __forceinline__ void operator()(const f32x4 (&acc)[2][2][4][2], const Unit& u, int wr, int wc, int fr, int fq) const {
        const int seg = u.pn >> 3, row0 = u.pm * BM + wr * 64 + fr, col0 = (u.pn & 7) * BM + wc * 32 + 8 * fq;
        const float k1 = -1.44269504f * sc, isc = 1.0f / sc, fcl = 30.f / sc;
        auto isilu = [k1, isc](float t) { return t * __builtin_amdgcn_rcpf(__builtin_fmaf(__builtin_amdgcn_exp2f(t * k1), isc, isc)); };
        float lv[2][8];
        if (seg == 1) {
#pragma unroll
            for (int bj = 0; bj < 2; ++bj) { const f32x4 l0 = *(const f32x4*)(lb + col0 + bj * HALF), l1 = *(const f32x4*)(lb + col0 + bj * HALF + 4);
                lv[bj][0] = l0[0]; lv[bj][1] = l0[1]; lv[bj][2] = l0[2]; lv[bj][3] = l0[3]; lv[bj][4] = l1[0]; lv[bj][5] = l1[1]; lv[bj][6] = l1[2]; lv[bj][7] = l1[3];
#pragma unroll
                for (int j = 0; j < 8; ++j) asm volatile("" : "+v"(lv[bj][j])); } }
#pragma unroll
        for (int ai = 0; ai < 2; ++ai)
#pragma unroll
            for (int m = 0; m < 4; ++m) {
                const int r = row0 + ai * HALF + m * 16; const size_t off = (size_t)r * 2048 + col0;
#pragma unroll
                for (int bj = 0; bj < 2; ++bj) {
                    const i32x4 i0 = __builtin_bit_cast(i32x4, acc[ai][bj][m][0]), i1 = __builtin_bit_cast(i32x4, acc[ai][bj][m][1]);
                    const float v[8] = {(float)i0[0], (float)i0[1], (float)i0[2], (float)i0[3], (float)i1[0], (float)i1[1], (float)i1[2], (float)i1[3]};
                    if (seg == 0) { u32x4 w; w.x = cvt_pk_bf16(isilu(v[0]), isilu(v[1])); w.y = cvt_pk_bf16(isilu(v[2]), isilu(v[3])); w.z = cvt_pk_bf16(isilu(v[4]), isilu(v[5])); w.w = cvt_pk_bf16(isilu(v[6]), isilu(v[7])); *(u32x4*)(Q + off + bj * HALF) = w; }
                    else if (seg == 1) {
                        float gl[8];
#pragma unroll
                        for (int j = 0; j < 8; ++j) { const float f = __builtin_amdgcn_fmed3f(v[j], -fcl, fcl), e = __builtin_amdgcn_exp2f(k1 * f), sg = __builtin_amdgcn_rcpf(1.f + e), om = 1.f - lv[bj][j];
                            gl[j] = __logf(lv[bj][j] + om * sg); }
                        u32x4 w; w.x = cvt_pk_bf16(gl[0], gl[1]); w.y = cvt_pk_bf16(gl[2], gl[3]); w.z = cvt_pk_bf16(gl[4], gl[5]); w.w = cvt_pk_bf16(gl[6], gl[7]); *(u32x4*)(Gl + off + bj * HALF) = w; }
                    else if (seg == 2) { u32x4 w; w.x = cvt_pk_bf16(v[0] * sc, v[1] * sc); w.y = cvt_pk_bf16(v[2] * sc, v[3] * sc); w.z = cvt_pk_bf16(v[4] * sc, v[5] * sc); w.w = cvt_pk_bf16(v[6] * sc, v[7] * sc); *(u32x4*)(Iv + off + bj * HALF) = w; }
                    else { u32x4 w; w.x = cvt_pk_bf16(isilu(v[0]), isilu(v[1])); w.y = cvt_pk_bf16(isilu(v[2]), isilu(v[3])); w.z = cvt_pk_bf16(isilu(v[4]), isilu(v[5])); w.w = cvt_pk_bf16(isilu(v[6]), isilu(v[7])); *(u32x4*)(Gt + off + bj * HALF) = w; }
                } }
    }
};

template <bool RB16, bool WF32> struct EpiResid {
    static constexpr bool PERM = false, AFTER_DRAIN = false, RSP = false, KEEPF = KF_DEFAULT;
    const float* resid; const bf16_t* rb16; float* out; bf16_t* xb; u64* rowss; unsigned char* x8; float sc8;
    __device__ __forceinline__ void operator()(const f32x4 (&acc)[2][2][4][2], const Unit& u, int wr, int wc, int fr, int fq) const {
        const int row0 = u.pm * BM + wr * 64 + fr, col0 = u.pn * BM + wc * 32 + 4 * fq;
#pragma unroll
        for (int ai = 0; ai < 2; ++ai) {
            f32x4 rv[4][4];
#pragma unroll
            for (int m = 0; m < 4; ++m) { const size_t off = (size_t)(row0 + ai * HALF + m * 16) * 2048 + col0;
#pragma unroll
                for (int q = 0; q < 4; ++q) { const int c = (q >> 1) * HALF + (q & 1) * 16;
                    if (RB16) { const u32x2 b = *(const u32x2*)(rb16 + off + c); rv[m][q] = (f32x4){__builtin_bit_cast(float, b.x << 16), __builtin_bit_cast(float, b.x & 0xffff0000u), __builtin_bit_cast(float, b.y << 16), __builtin_bit_cast(float, b.y & 0xffff0000u)}; }
                    else rv[m][q] = *(const f32x4*)(resid + off + c); } }
#pragma unroll
            for (int m = 0; m < 4; ++m) { const int r = row0 + ai * HALF + m * 16; const size_t off = (size_t)r * 2048 + col0; float ss = 0.f;
#pragma unroll
                for (int q = 0; q < 4; ++q) { const int c = (q >> 1) * HALF + (q & 1) * 16;
                    const f32x4 v = rv[m][q] + acc[ai][q >> 1][m][q & 1]; if (WF32) *(f32x4*)(out + off + c) = v; ss += (v[0] * v[0] + v[1] * v[1]) + (v[2] * v[2] + v[3] * v[3]);
                    if (xb) { u32x2 p; p.x = cvt_pk_bf16(v[0], v[1]); p.y = cvt_pk_bf16(v[2], v[3]); *(u32x2*)(xb + off + c) = p; }
                    if (x8) *(unsigned*)(x8 + off + c) = pk4_i8(v[0] * sc8, v[1] * sc8, v[2] * sc8, v[3] * sc8); }
                if (rowss) { ss += __shfl_xor(ss, 16); ss += __shfl_xor(ss, 32); if (fq == 0) fx_add(rowss + r, ss); } }
            asm volatile("" ::: "memory"); }
    }
};

struct EpiResidB16 {
    static constexpr bool PERM = true, AFTER_DRAIN = false, RSP = false, KEEPF = KF_DEFAULT;
    const bf16_t* rb16; bf16_t* xb; u64* rowss; unsigned char* x8; float sc8;
    __device__ __forceinline__ void operator()(const f32x4 (&acc)[2][2][4][2], const Unit& u, int wr, int wc, int fr, int fq) const {
        const int row0 = u.pm * BM + wr * 64 + fr, col0 = u.pn * BM + wc * 32 + 8 * fq;
#pragma unroll
        for (int ai = 0; ai < 2; ++ai) {
            u32x4 rv[4][2];
#pragma unroll
            for (int m = 0; m < 4; ++m) { const size_t off = (size_t)(row0 + ai * HALF + m * 16) * 2048 + col0;
#pragma unroll
                for (int bj = 0; bj < 2; ++bj) rv[m][bj] = *(const u32x4*)(rb16 + off + bj * HALF); }
#pragma unroll
            for (int m = 0; m < 4; ++m) { const int r = row0 + ai * HALF + m * 16; const size_t off = (size_t)r * 2048 + col0; float ss = 0.f;
#pragma unroll
                for (int bj = 0; bj < 2; ++bj) { const u32x4 b = rv[m][bj]; const f32x4 a0 = acc[ai][bj][m][0], a1 = acc[ai][bj][m][1];
                    const float v0 = __builtin_bit_cast(float, b.x << 16) + a0[0], v1 = __builtin_bit_cast(float, b.x & 0xffff0000u) + a0[1], v2 = __builtin_bit_cast(float, b.y << 16) + a0[2], v3 = __builtin_bit_cast(float, b.y & 0xffff0000u) + a0[3];
                    const float v4 = __builtin_bit_cast(float, b.z << 16) + a1[0], v5 = __builtin_bit_cast(float, b.z & 0xffff0000u) + a1[1], v6 = __builtin_bit_cast(float, b.w << 16) + a1[2], v7 = __builtin_bit_cast(float, b.w & 0xffff0000u) + a1[3];
                    ss += ((v0 * v0 + v1 * v1) + (v2 * v2 + v3 * v3)) + ((v4 * v4 + v5 * v5) + (v6 * v6 + v7 * v7));
                    u32x4 p; p.x = cvt_pk_bf16(v0, v1); p.y = cvt_pk_bf16(v2, v3); p.z = cvt_pk_bf16(v4, v5); p.w = cvt_pk_bf16(v6, v7);
                    *(u32x4*)(xb + off + bj * HALF) = p;
                    if (x8) { u32x2 q; q.x = pk4_i8(v0 * sc8, v1 * sc8, v2 * sc8, v3 * sc8); q.y = pk4_i8(v4 * sc8, v5 * sc8, v6 * sc8, v7 * sc8); *(u32x2*)(x8 + off + bj * HALF) = q; } }
                if (rowss) { ss += __shfl_xor(ss, 16); ss += __shfl_xor(ss, 32); if (fq == 0) fx_add(rowss + r, ss); } }
            asm volatile("" ::: "memory"); }
    }
};

template <bool RSD> struct EpiSwiglu {
    static constexpr bool PERM = true, AFTER_DRAIN = false, RSP = false, KEEPF = KF_DEFAULT;
    const void* rsv; bf16_t* H; int ldh;
    __device__ __forceinline__ void operator()(const f32x4 (&acc)[2][2][4][2], const Unit& u, int wr, int wc, int fr, int fq) const {
        const int row0 = u.pm * BM + wr * 64 + fr, col0 = u.pn * HALF + wc * 32 + 8 * fq;
        float rsa[8];
#pragma unroll
        for (int i = 0; i < 8; ++i) { const int r = row0 + (i >> 2) * HALF + (i & 3) * 16; rsa[i] = RSD ? ((const float*)rsv)[r] : fx_get((const u64*)rsv + r); }
        if (!RSD) {
#pragma unroll
            for (int i = 0; i < 8; ++i) rsa[i] = 1.0f / sqrtf(rsa[i] * INV_D + RMS_EPS); }
#pragma unroll
        for (int ai = 0; ai < 2; ++ai)
#pragma unroll
            for (int m = 0; m < 4; ++m) {
                const int r = row0 + ai * HALF + m * 16; const float rs = rsa[ai * 4 + m];
                const f32x4 g0 = acc[ai][0][m][0] * rs, g1 = acc[ai][0][m][1] * rs, u0 = acc[ai][1][m][0] * rs, u1 = acc[ai][1][m][1] * rs;
                u32x4 w; w.x = cvt_pk_bf16(fsilu(g0[0]) * u0[0], fsilu(g0[1]) * u0[1]); w.y = cvt_pk_bf16(fsilu(g0[2]) * u0[2], fsilu(g0[3]) * u0[3]);
                w.z = cvt_pk_bf16(fsilu(g1[0]) * u1[0], fsilu(g1[1]) * u1[1]); w.w = cvt_pk_bf16(fsilu(g1[2]) * u1[2], fsilu(g1[3]) * u1[3]);
                *(u32x4*)(H + (size_t)r * ldh + col0) = w; }
    }
};

struct EpiSwiglu8 {
    static constexpr bool PERM = true, AFTER_DRAIN = false, RSP = false, KEEPF = false;
    unsigned char* H; int ldh; float sc_in, sc_out;
    __device__ __forceinline__ void operator()(const f32x4 (&acc)[2][2][4][2], const Unit& u, int wr, int wc, int fr, int fq) const {
        const int row0 = u.pm * BM + wr * 64 + fr, col0 = u.pn * HALF + wc * 32 + 8 * fq;
        const float k1 = -1.44269504f * sc_in, k2i = __builtin_amdgcn_rcpf(sc_in * sc_in * sc_out);
#pragma unroll
        for (int ai = 0; ai < 2; ++ai)
#pragma unroll
            for (int m = 0; m < 4; ++m) {
                const int r = row0 + ai * HALF + m * 16;
                const f32x4 g0 = acc[ai][0][m][0], g1 = acc[ai][0][m][1], u0 = acc[ai][1][m][0], u1 = acc[ai][1][m][1];
                float h[8];
#pragma unroll
                for (int j = 0; j < 4; ++j) { h[j] = (g0[j] * u0[j]) * __builtin_amdgcn_rcpf(__builtin_fmaf(__builtin_amdgcn_exp2f(g0[j] * k1), k2i, k2i)); h[4 + j] = (g1[j] * u1[j]) * __builtin_amdgcn_rcpf(__builtin_fmaf(__builtin_amdgcn_exp2f(g1[j] * k1), k2i, k2i)); }
                u32x2 w; w.x = pk4_fp8(h[0], h[1], h[2], h[3]); w.y = pk4_fp8(h[4], h[5], h[6], h[7]);
                *(u32x2*)(H + (size_t)r * ldh + col0) = w; }
    }
};

template <bool ROWRS, bool OUT8> struct EpiSwigluI {
    static constexpr bool PERM = true, AFTER_DRAIN = false, RSP = ROWRS, KEEPF = KF_SWIGLU;
    void* H; int ldh; float sc_in, sc_out; const u64* rss;
    __device__ __forceinline__ void prefetch(const Unit& u, PG8_LAS unsigned char* lds, int wid, int slot) const { rs_prefetch(rss, u.pm, lds, wid, slot); }
    __device__ __forceinline__ void operator()(const f32x4 (&acc)[2][2][4][2], const Unit& u, int wr, int wc, int fr, int fq, const PG8_LAS unsigned char* rsl = nullptr) const {
        const int row0 = u.pm * BM + wr * 64 + fr, col0 = u.pn * HALF + wc * 32 + 8 * fq;
        float rsa[8];
        if (ROWRS) {
#pragma unroll
            for (int i = 0; i < 8; ++i) rsa[i] = fx_rs_lds((const PG8_LAS u64*)rsl + wr * 64 + fr + (i >> 2) * HALF + (i & 3) * 16, sc_in); }
#pragma unroll
        for (int ai = 0; ai < 2; ++ai)
#pragma unroll
            for (int m = 0; m < 4; ++m) {
                const int r = row0 + ai * HALF + m * 16; const float s = ROWRS ? rsa[ai * 4 + m] : sc_in, k1 = -1.44269504f * s, k2i = __builtin_amdgcn_rcpf(OUT8 ? s * s * sc_out : s * s);
                const i32x4 gi0 = __builtin_bit_cast(i32x4, acc[ai][0][m][0]), gi1 = __builtin_bit_cast(i32x4, acc[ai][0][m][1]), ui0 = __builtin_bit_cast(i32x4, acc[ai][1][m][0]), ui1 = __builtin_bit_cast(i32x4, acc[ai][1][m][1]);
                float h[8];
#pragma unroll
                for (int j = 0; j < 4; ++j) { const float g0 = (float)gi0[j], g1 = (float)gi1[j];
                    h[j] = (g0 * (float)ui0[j]) * __builtin_amdgcn_rcpf(__builtin_fmaf(__builtin_amdgcn_exp2f(g0 * k1), k2i, k2i)); h[4 + j] = (g1 * (float)ui1[j]) * __builtin_amdgcn_rcpf(__builtin_fmaf(__builtin_amdgcn_exp2f(g1 * k1), k2i, k2i)); }
                if (OUT8) { u32x2 w; w.x = pk4_fp8(h[0], h[1], h[2], h[3]); w.y = pk4_fp8(h[4], h[5], h[6], h[7]); *(u32x2*)((unsigned char*)H + (size_t)r * ldh + col0) = w; }
                else { u32x4 w; w.x = cvt_pk_bf16(h[0], h[1]); w.y = cvt_pk_bf16(h[2], h[3]); w.z = cvt_pk_bf16(h[4], h[5]); w.w = cvt_pk_bf16(h[6], h[7]); *(u32x4*)((bf16_t*)H + (size_t)r * ldh + col0) = w; } }
    }
};

struct EpiBf16Plain {
    static constexpr bool PERM = true, AFTER_DRAIN = false, RSP = false, KEEPF = KF_DEFAULT;
    bf16_t* O;
    __device__ __forceinline__ void operator()(const f32x4 (&acc)[2][2][4][2], const Unit& u, int wr, int wc, int fr, int fq) const {
        const int row0 = u.pm * BM + wr * 64 + fr, col0 = u.pn * BM + wc * 32 + 8 * fq;
#pragma unroll
        for (int ai = 0; ai < 2; ++ai)
#pragma unroll
            for (int m = 0; m < 4; ++m) { bf16_t* rowp = O + (size_t)(row0 + ai * HALF + m * 16) * 2048 + col0;
#pragma unroll
                for (int bj = 0; bj < 2; ++bj) { const f32x4 v0 = acc[ai][bj][m][0], v1 = acc[ai][bj][m][1];
                    u32x4 p; p.x = cvt_pk_bf16(v0[0], v0[1]); p.y = cvt_pk_bf16(v0[2], v0[3]); p.z = cvt_pk_bf16(v1[0], v1[1]); p.w = cvt_pk_bf16(v1[2], v1[3]);
                    *(u32x4*)(rowp + bj * HALF) = p; } }
    }
};

struct EpiY {
    static constexpr bool PERM = true, AFTER_DRAIN = false, RSP = false, KEEPF = KF_DEFAULT;
    bf16_t* Y; const int* row_tok; const float* row_w; float sc;
    __device__ __forceinline__ void operator()(const f32x4 (&acc)[2][2][4][2], const Unit& u, int wr, int wc, int fr, int fq) const {
        const int row0 = u.pm * BM + wr * 64 + fr, col0 = u.pn * BM + wc * 32 + 8 * fq;
        int orow[8]; float wv[8];
#pragma unroll
        for (int i = 0; i < 8; ++i) { const int r = row0 + (i >> 2) * HALF + (i & 3) * 16; orow[i] = row_tok[r]; wv[i] = row_w[r]; }
#pragma unroll
        for (int i = 0; i < 8; ++i) asm volatile("" : "+v"(orow[i]), "+v"(wv[i]));
#pragma unroll
        for (int ai = 0; ai < 2; ++ai)
#pragma unroll
            for (int m = 0; m < 4; ++m) { const int o = orow[ai * 4 + m]; const float w = wv[ai * 4 + m] * sc;
                if (o >= 0) {
#pragma unroll
                    for (int bj = 0; bj < 2; ++bj) { const f32x4 v0 = acc[ai][bj][m][0] * w, v1 = acc[ai][bj][m][1] * w;
                        u32x4 p; p.x = cvt_pk_bf16(v0[0], v0[1]); p.y = cvt_pk_bf16(v0[2], v0[3]); p.z = cvt_pk_bf16(v1[0], v1[1]); p.w = cvt_pk_bf16(v1[2], v1[3]);
                        *(u32x4*)(Y + (size_t)o * 2048 + col0 + bj * HALF) = p; } } }
    }
};

struct EpiNull {
    static constexpr bool PERM = true, AFTER_DRAIN = false, RSP = false, KEEPF = KF_DEFAULT;
    bf16_t* H; int ldh;
    __device__ __forceinline__ void operator()(const f32x4 (&acc)[2][2][4][2], const Unit& u, int wr, int wc, int fr, int fq) const {
        const int row0 = u.pm * BM + wr * 64 + fr, col0 = u.pn * HALF + wc * 32 + 8 * fq;
#pragma unroll
        for (int ai = 0; ai < 2; ++ai)
#pragma unroll
            for (int m = 0; m < 4; ++m) { const int r = row0 + ai * HALF + m * 16;
                const f32x4 s = (acc[ai][0][m][0] + acc[ai][0][m][1]) + (acc[ai][1][m][0] + acc[ai][1][m][1]);
                u32x4 w; w.x = __builtin_bit_cast(unsigned, s[0]); w.y = __builtin_bit_cast(unsigned, s[1]); w.z = __builtin_bit_cast(unsigned, s[2]); w.w = __builtin_bit_cast(unsigned, s[3]);
                *(u32x4*)(H + (size_t)r * ldh + col0) = w; }
    }
};

struct EpiSguIn {
    static constexpr bool PERM = true, AFTER_DRAIN = false, RSP = true, KEEPF = KF_SGU;
    const u64* rowss; bf16_t *U, *V; u64* stats; float sc_in;
    __device__ __forceinline__ void prefetch(const Unit& u, PG8_LAS unsigned char* lds, int wid, int slot) const { rs_prefetch(rowss, u.pm, lds, wid, slot); }
    __device__ __forceinline__ void operator()(const f32x4 (&acc)[2][2][4][2], const Unit& u, int wr, int wc, int fr, int fq, const PG8_LAS unsigned char* rsl) const {
        const bool isv = u.pn >= 8; const int row0 = u.pm * BM + wr * 64 + fr, col0 = (u.pn & 7) * BM + wc * 32 + 8 * fq; bf16_t* base = isv ? V : U;
        float rsa[8];
#pragma unroll
        for (int i = 0; i < 8; ++i) rsa[i] = fx_rs_lds((const PG8_LAS u64*)rsl + wr * 64 + fr + (i >> 2) * HALF + (i & 3) * 16, sc_in);
#pragma unroll
        for (int ai = 0; ai < 2; ++ai)
#pragma unroll
            for (int m = 0; m < 4; ++m) {
                const int r = row0 + ai * HALF + m * 16; const float rs = rsa[ai * 4 + m]; float s1 = 0.f, s2 = 0.f;
#pragma unroll
                for (int bj = 0; bj < 2; ++bj) {
                    const i32x4 i0 = __builtin_bit_cast(i32x4, acc[ai][bj][m][0]), i1 = __builtin_bit_cast(i32x4, acc[ai][bj][m][1]);
                    const f32x4 v0 = (f32x4){(float)i0[0], (float)i0[1], (float)i0[2], (float)i0[3]} * rs, v1 = (f32x4){(float)i1[0], (float)i1[1], (float)i1[2], (float)i1[3]} * rs;
                    const f32x2 a = gelu_pk((f32x2){v0[0], v0[1]}), b = gelu_pk((f32x2){v0[2], v0[3]}), c = gelu_pk((f32x2){v1[0], v1[1]}), d = gelu_pk((f32x2){v1[2], v1[3]});
                    s1 += (a.x + a.y) + (b.x + b.y) + (c.x + c.y) + (d.x + d.y); s2 += (a.x * a.x + a.y * a.y) + (b.x * b.x + b.y * b.y) + (c.x * c.x + c.y * c.y) + (d.x * d.x + d.y * d.y);
                    u32x4 w; w.x = cvt_pk_bf16(a.x, a.y); w.y = cvt_pk_bf16(b.x, b.y); w.z = cvt_pk_bf16(c.x, c.y); w.w = cvt_pk_bf16(d.x, d.y);
                    *(u32x4*)(base + (size_t)r * 2048 + col0 + bj * HALF) = w; }
                if (isv) { s1 += __shfl_xor(s1, 16); s1 += __shfl_xor(s1, 32); s2 += __shfl_xor(s2, 16); s2 += __shfl_xor(s2, 32);
                    if (fq == 0) { fx_add(stats + 2 * r, s1); fx_add(stats + 2 * r + 1, s2); } } }
    }
};

template <class Epi, class Sched, bool ALIGN_EPI = false, bool SP2 = false, bool F8 = false, bool I8 = false>
__device__ __forceinline__ void gemm_phase(PG8_LAS unsigned char* lds, const Gemm g, const Sched& S, const Epi& E, const int wv  ) {
    int tid_ = wv * 64 + (int)__builtin_amdgcn_mbcnt_hi(~0u, __builtin_amdgcn_mbcnt_lo(~0u, 0u)); asm volatile("" : "+v"(tid_));
    const int tid = tid_, wid = __builtin_amdgcn_readfirstlane(tid >> 6), lane = tid & 63, wr = wid >> 2, wc = wid & 3, fr = lane & 15, fq = lane >> 4;
    const int K = g.K, nt = K / BK;
    unsigned voffA[2], voffB[2];
#pragma unroll
    for (int i = 0; i < 2; ++i) { int R, C; stage_rc(tid * 16 + i * 8192, R, C); const int Rb = Epi::PERM ? ((R & ~31) + perm32(R & 31)) : R;
        voffA[i] = (unsigned)(R * K + C) * 2u; voffB[i] = (unsigned)(Rb * K + C) * 2u; }
    const size_t kstep = (size_t)(BK * 2);
    const size_t hstep = (size_t)HALF * K * 2;
    const size_t tstep = 2 * hstep;
    const unsigned ldsw = (unsigned)wid * 1024u;
    const unsigned lds_w = __builtin_amdgcn_readfirstlane((unsigned)(size_t)lds + ldsw);
    const int aoff = lds_byte(wr * 64 + fr, fq * 8), boff = lds_byte(wc * 32 + fr, fq * 8);
#define PG8_SA(b, h) (((b) * 2 + (h)) * HTB)
#define PG8_SB(b, h) ((4 + (b) * 2 + (h)) * HTB)
#define PG8_STAGE(bufoff, gbase, voff) do { \
        if constexpr (F8 || ASM_STAGE) { glds16_s<(bufoff)>((const void*)(gbase), (voff)[0], lds_w); glds16_s<(bufoff) + 8192>((const void*)(gbase), (voff)[1], lds_w); } \
        else { _Pragma("unroll") for (int _i = 0; _i < 2; ++_i) __builtin_amdgcn_global_load_lds((const unsigned*)((const char*)(gbase) + (voff)[_i]), (PG8_LAS unsigned*)(lds + (bufoff) + ldsw + _i * 8192), 16, 0, 0); } } while (0)
#define PG8_LDA(dst, b, h) do { _Pragma("unroll") for (int m = 0; m < 4; ++m) _Pragma("unroll") for (int k = 0; k < 2; ++k) dst[m][k] = *(const PG8_LAS bf16x8*)(lds + PG8_SA(b, h) + aoff + m * 2048 + k * 1024); } while (0)
#define PG8_LDB(dst, b, h) do { _Pragma("unroll") for (int n = 0; n < 2; ++n) _Pragma("unroll") for (int k = 0; k < 2; ++k) dst[n][k] = *(const PG8_LAS bf16x8*)(lds + PG8_SB(b, h) + boff + n * 2048 + k * 1024); } while (0)
#define PG8_MMA(ai, bj, At, Bt) PG8_MMAX(ai, bj, At, Bt, false)
#define PG8_MMAX(ai, bj, At, Bt, Z) do { __builtin_amdgcn_s_setprio(1); const f32x4 z4_ = (f32x4){0.f, 0.f, 0.f, 0.f}; (void)z4_; \
        if constexpr (F8) { _Pragma("unroll") for (int m = 0; m < 4; ++m) _Pragma("unroll") for (int n = 0; n < 2; ++n) \
            acc[ai][bj][m][n] = __builtin_amdgcn_mfma_scale_f32_16x16x128_f8f6f4(cat8(Bt[n][0], Bt[n][1]), cat8(At[m][0], At[m][1]), (Z) ? z4_ : acc[ai][bj][m][n], 0, 0, 0, 0, 0, 0); } \
        else if constexpr (I8) { _Pragma("unroll") for (int m = 0; m < 4; ++m) _Pragma("unroll") for (int n = 0; n < 2; ++n) _Pragma("unroll") for (int k = 0; k < 2; ++k) \
            acc[ai][bj][m][n] = __builtin_bit_cast(f32x4, __builtin_amdgcn_mfma_i32_16x16x64_i8(__builtin_bit_cast(i32x4, Bt[n][k]), __builtin_bit_cast(i32x4, At[m][k]), __builtin_bit_cast(i32x4, ((Z) && k == 0) ? z4_ : acc[ai][bj][m][n]), 0, 0, 0)); } \
        else { _Pragma("unroll") for (int m = 0; m < 4; ++m) _Pragma("unroll") for (int n = 0; n < 2; ++n) _Pragma("unroll") for (int k = 0; k < 2; ++k) \
            acc[ai][bj][m][n] = __builtin_amdgcn_mfma_f32_16x16x32_bf16(Bt[n][k], At[m][k], ((Z) && k == 0) ? z4_ : acc[ai][bj][m][n], 0, 0, 0); } \
        __builtin_amdgcn_s_setprio(0); } while (0)
#define PG8_WAIT_V(n) asm volatile("s_waitcnt vmcnt(" #n ")" ::: "memory")
#define PG8_WAIT_L(n) asm volatile("s_waitcnt lgkmcnt(" #n ")" ::: "memory")
#define PG8_BAR __builtin_amdgcn_s_barrier()
#define PG8_SCHED __builtin_amdgcn_sched_barrier(0)
    Unit cur, nxt; int ui = 0;
    if (!S.next(0, cur)) return;
    f32x4 acc[2][2][4][2];
#pragma unroll
    for (int a = 0; a < 2; ++a)
#pragma unroll
        for (int b = 0; b < 2; ++b)
#pragma unroll
            for (int m = 0; m < 4; ++m)
#pragma unroll
                for (int n = 0; n < 2; ++n) { if constexpr (!SP2) acc[a][b][m][n] = (f32x4){0.f, 0.f, 0.f, 0.f}; }
    bf16x8 At[4][2], B0[2][2], B1[2][2];
    const char* cA = (const char*)g.A + (size_t)cur.pm * tstep; const char* cB = (const char*)g.Bt + (size_t)cur.e * g.estride + (size_t)cur.pn * tstep;
    S.a_ready(cur);
    if constexpr (Epi::RSP) E.prefetch(cur, lds, wid, 0);
    if constexpr (SP2) {
        PG8_STAGE(PG8_SB(0, 0), cB, voffB); PG8_STAGE(PG8_SB(0, 1), cB + hstep, voffB); PG8_STAGE(PG8_SA(0, 0), cA, voffA); PG8_STAGE(PG8_SA(0, 1), cA + hstep, voffA);
        if (wr == 1) PG8_BAR;
        PG8_WAIT_V(2); PG8_BAR;
        PG8_STAGE(PG8_SB(1, 0), cB + kstep, voffB); PG8_STAGE(PG8_SA(1, 0), cA + kstep, voffA); PG8_STAGE(PG8_SB(1, 1), cB + hstep + kstep, voffB);
        PG8_WAIT_V(6); PG8_BAR;
    } else {
        PG8_STAGE(PG8_SB(0, 0), cB, voffB); PG8_STAGE(PG8_SA(0, 0), cA, voffA); PG8_STAGE(PG8_SB(0, 1), cB + hstep, voffB); PG8_STAGE(PG8_SA(0, 1), cA + hstep, voffA);
        if (wr == 1) PG8_BAR;
        PG8_WAIT_V(4); PG8_BAR;
        PG8_STAGE(PG8_SB(1, 0), cB + kstep, voffB); PG8_STAGE(PG8_SA(1, 0), cA + kstep, voffA); PG8_STAGE(PG8_SB(1, 1), cB + hstep + kstep, voffB);
        PG8_WAIT_V(6); PG8_BAR;
    }
    for (;;) {
        const bool has_next = S.next(ui + 1, nxt);
        const char* nA = has_next ? (const char*)g.A + (size_t)nxt.pm * tstep : cA; const char* nB = has_next ? (const char*)g.Bt + (size_t)nxt.e * g.estride + (size_t)nxt.pn * tstep : cB;
        for (int t = 0; t < nt; t += 2) {
            const bool last = (t == nt - 2);
            const char* a1 = cA + (size_t)(t + 1) * kstep;
            const char* a2 = last ? nA : cA + (size_t)(t + 2) * kstep; const char* b2 = last ? nB : cB + (size_t)(t + 2) * kstep;
            const char* a3 = a2 + kstep; const char* b3 = b2 + kstep;
            if (last && has_next) { S.a_ready(nxt); if constexpr (Epi::RSP) E.prefetch(nxt, lds, wid, (ui + 1) & 1); }
            if constexpr (SP2) {
            PG8_LDB(B0, 0, 0); PG8_LDB(B1, 0, 1); PG8_SCHED; PG8_LDA(At, 0, 0); PG8_STAGE(PG8_SA(1, 1), a1 + hstep, voffA);
            PG8_WAIT_V(8); PG8_WAIT_L(0); PG8_BAR; if (t == 0) { PG8_MMAX(0, 0, At, B0, true); PG8_MMAX(0, 1, At, B1, true); } else { PG8_MMA(0, 0, At, B0); PG8_MMA(0, 1, At, B1); } PG8_BAR; PG8_SCHED;
            PG8_LDA(At, 0, 1); PG8_STAGE(PG8_SB(0, 0), b2, voffB); PG8_STAGE(PG8_SB(0, 1), b2 + hstep, voffB); PG8_STAGE(PG8_SA(0, 0), a2, voffA);
            PG8_WAIT_V(8); PG8_WAIT_L(0); PG8_BAR; if (t == 0) { PG8_MMAX(1, 0, At, B0, true); PG8_MMAX(1, 1, At, B1, true); } else { PG8_MMA(1, 0, At, B0); PG8_MMA(1, 1, At, B1); } PG8_BAR; PG8_SCHED;
            PG8_LDB(B0, 1, 0); PG8_LDB(B1, 1, 1); PG8_SCHED; PG8_LDA(At, 1, 0); PG8_STAGE(PG8_SA(0, 1), a2 + hstep, voffA);
            PG8_WAIT_V(8); PG8_WAIT_L(0); PG8_BAR; PG8_MMA(0, 0, At, B0); PG8_MMA(0, 1, At, B1); PG8_BAR; PG8_SCHED;
            PG8_LDA(At, 1, 1); PG8_STAGE(PG8_SB(1, 0), b3, voffB); PG8_STAGE(PG8_SB(1, 1), b3 + hstep, voffB); PG8_STAGE(PG8_SA(1, 0), a3, voffA);
            PG8_WAIT_V(8); PG8_WAIT_L(0); PG8_BAR; PG8_MMA(1, 0, At, B0); PG8_MMA(1, 1, At, B1); PG8_BAR; PG8_SCHED;
            } else {
            PG8_LDB(B0, 0, 0); PG8_SCHED; PG8_LDA(At, 0, 0); PG8_STAGE(PG8_SA(1, 1), a1 + hstep, voffA);
            PG8_WAIT_L(8); PG8_BAR; PG8_WAIT_L(0); PG8_MMA(0, 0, At, B0); PG8_BAR; PG8_SCHED;
            PG8_LDB(B1, 0, 1); PG8_STAGE(PG8_SB(0, 0), b2, voffB);
            PG8_BAR; PG8_WAIT_L(0); PG8_MMA(0, 1, At, B1); PG8_BAR;
            PG8_LDA(At, 0, 1); PG8_STAGE(PG8_SA(0, 0), a2, voffA);
            PG8_BAR; PG8_WAIT_L(0); PG8_MMA(1, 0, At, B0); PG8_BAR; PG8_SCHED;
            PG8_STAGE(PG8_SB(0, 1), b2 + hstep, voffB);
            PG8_WAIT_V(6); PG8_BAR; PG8_MMA(1, 1, At, B1); PG8_BAR;
            PG8_LDB(B0, 1, 0); PG8_SCHED; PG8_LDA(At, 1, 0); PG8_STAGE(PG8_SA(0, 1), a2 + hstep, voffA);
            PG8_WAIT_L(8); PG8_BAR; PG8_WAIT_L(0); PG8_MMA(0, 0, At, B0); PG8_BAR; PG8_SCHED;
            PG8_LDB(B1, 1, 1); PG8_STAGE(PG8_SB(1, 0), b3, voffB);
            PG8_BAR; PG8_WAIT_L(0); PG8_MMA(0, 1, At, B1); PG8_BAR;
            PG8_LDA(At, 1, 1); PG8_STAGE(PG8_SA(1, 0), a3, voffA);
            PG8_BAR; PG8_WAIT_L(0); PG8_MMA(1, 0, At, B0); PG8_BAR; PG8_SCHED;
            PG8_STAGE(PG8_SB(1, 1), b3 + hstep, voffB);
            PG8_WAIT_V(6); PG8_BAR; PG8_MMA(1, 1, At, B1); PG8_BAR;
            }
        }
        if constexpr (ALIGN_EPI) { if (wr == 0) PG8_BAR; }
        if constexpr (!Epi::AFTER_DRAIN) { { int l2_ = (int)__builtin_amdgcn_mbcnt_hi(~0u, __builtin_amdgcn_mbcnt_lo(~0u, 0u)); asm volatile("" : "+v"(l2_)); if constexpr (Epi::RSP) E(acc, cur, wr, wc, l2_ & 15, l2_ >> 4, (const PG8_LAS unsigned char*)(lds + RSL_OFF + (ui & 1) * 2048)); else E(acc, cur, wr, wc, l2_ & 15, l2_ >> 4); } S.done(cur);     if constexpr (Epi::KEEPF) { _Pragma("unroll") for (int m_ = 0; m_ < 4; ++m_) _Pragma("unroll") for (int k_ = 0; k_ < 2; ++k_) asm volatile("" :: "v"(At[m_][k_])); _Pragma("unroll") for (int n_ = 0; n_ < 2; ++n_) _Pragma("unroll") for (int k_ = 0; k_ < 2; ++k_) asm volatile("" :: "v"(B0[n_][k_]), "v"(B1[n_][k_])); } }
        if (!has_next) break;
#pragma unroll
        for (int a = 0; a < 2; ++a)
#pragma unroll
            for (int b = 0; b < 2; ++b)
#pragma unroll
                for (int m = 0; m < 4; ++m)
#pragma unroll
                    for (int n = 0; n < 2; ++n) { if constexpr (!SP2) acc[a][b][m][n] = (f32x4){0.f, 0.f, 0.f, 0.f}; }
        cur = nxt; cA = nA; cB = nB; ++ui;
        if constexpr (ALIGN_EPI) { if (wr == 1) PG8_BAR; }
    }
    PG8_WAIT_V(0);
    if constexpr (!ALIGN_EPI) { if (wr == 0) PG8_BAR; }
    PG8_BAR;
    if constexpr (Epi::AFTER_DRAIN) { E.fused(acc, cur, wr, wc, fr, fq, lds, wid, lane); S.done(cur); }
#undef PG8_SA
#undef PG8_SB
#undef PG8_STAGE
#undef PG8_LDA
#undef PG8_LDB
#undef PG8_MMA
#undef PG8_WAIT_V
#undef PG8_WAIT_L
#undef PG8_BAR
#undef PG8_SCHED
}
}


constexpr int BATCH = 16, SEQ = 2048, D = 2048, M = BATCH * SEQ;
constexpr int NH = 16, DK = 128, DV = 128, CH = 64, NCH = SEQ / CH;
constexpr int DFF = 5632, NE = 8, DFFE = 7168;
constexpr int SROWS = 34816;
constexpr float EPS = 1e-6f;
constexpr float F8_SA = 16.f, F8_SW_UP = 512.f, F8_SH = 8.f, F8_SW_DN = 1024.f;
constexpr float I8_SA = 31.75f, I8_SA_X1 = 27.f, I8_SA_X2 = 24.f, I8_SW = 1437.f;
constexpr int NPH = 16;
#ifndef F8SP2
#define F8SP2 true
#endif
constexpr int NWAVES = 8;

constexpr size_t MiB = 1u << 20;
constexpr size_t WS_CTL = 0, CTL_ZERO_BYTES = 2 * MiB;
constexpr size_t WS_RSS1 = 1 * MiB, WS_RSS2 = WS_RSS1 + 256 * 1024, WS_LNST = WS_RSS2 + 256 * 1024;
static_assert(WS_LNST + 512 * 1024 <= CTL_ZERO_BYTES, "zeroed region");
constexpr size_t WS_SMALL = 2 * MiB;
constexpr size_t WS_RSS0 = WS_SMALL, WS_LB = WS_RSS0 + 128 * 1024, WS_TOKE = WS_LB + 8192, WS_TOKP = WS_TOKE + 256 * 1024, WS_TOKW = WS_TOKP + 256 * 1024, WS_TOKRS = WS_TOKW + 256 * 1024;
constexpr size_t WS_ROWTOK = WS_TOKRS + 128 * 1024, WS_ROWW = WS_ROWTOK + 2 * SROWS * 4, WS_ROWRS = WS_ROWW + 2 * SROWS * 4, WS_PANE = WS_ROWRS + 2 * SROWS * 4;
constexpr size_t WS_NPAN = WS_PANE + 2 * 160 * 4;
static_assert(WS_NPAN + 64 <= 6 * MiB, "small region");
constexpr size_t WS_W_HIN = 6 * MiB, WS_W_HOUT = WS_W_HIN + 32 * MiB, WS_W_FGU = WS_W_HOUT + 8 * MiB, WS_W_FD = WS_W_FGU + 44 * MiB, WS_W_SIN = WS_W_FD + 22 * MiB, WS_W_SOUT = WS_W_SIN + 16 * MiB;
constexpr size_t WS_W_MGU = WS_W_SOUT + 8 * MiB, WS_W_MD = WS_W_MGU + 448 * MiB, WS_XB = WS_W_MD + 224 * MiB, WS_R = WS_XB + 128 * MiB;
constexpr size_t R_Q = 0, R_K = 128 * MiB, R_G = 256 * MiB, R_I = 384 * MiB, R_GT = 512 * MiB;
constexpr size_t R_HFF = 0;
constexpr size_t R_U = 0, R_V = 128 * MiB;
constexpr size_t R_AS = 0, R_H = 272 * MiB, R_Y = 0;
constexpr size_t WS_YS = WS_R + 748 * MiB;
constexpr size_t WS_O = WS_R + 748 * MiB;
constexpr size_t WS_END = WS_O + 128 * MiB;
static_assert((size_t)SROWS * 2048 * 2 == 136 * MiB && (size_t)SROWS * 7168 * 2 == 476 * MiB, "expert buffers");
constexpr int CW_BAR = 4096;
constexpr int CW_CNT = 8192;

constexpr int LDS_BYTES = 147456;
constexpr int MISC_OFF = LDS_BYTES - 256;

#define GAS __attribute__((address_space(1)))
#define LAS __attribute__((address_space(3)))
typedef unsigned short bf16;
typedef unsigned v4u __attribute__((ext_vector_type(4)));
typedef unsigned v2u __attribute__((ext_vector_type(2)));
typedef float f32x4 __attribute__((ext_vector_type(4)));
typedef float f32x16 __attribute__((ext_vector_type(16)));
typedef short bf16x8 __attribute__((ext_vector_type(8)));
#define LDS_WAIT() asm volatile("s_waitcnt lgkmcnt(0)" ::: "memory")
#define VM_WAIT() asm volatile("s_waitcnt vmcnt(0)" ::: "memory")
#define WG_BAR() do { asm volatile("s_waitcnt lgkmcnt(0)" ::: "memory"); __builtin_amdgcn_s_barrier(); asm volatile("" ::: "memory"); } while (0)
__device__ __forceinline__ unsigned pk2(float lo, float hi) { return pg8::cvt_pk_bf16(lo, hi); }
__device__ __forceinline__ unsigned f2bf(float f) { return pg8::cvt_pk_bf16(f, 0.f) & 0xffffu; }
__device__ __forceinline__ float bf2f(unsigned short b) { return __builtin_bit_cast(float, (unsigned)b << 16); }
__device__ __forceinline__ float bflo(unsigned w) { return __builtin_bit_cast(float, w << 16); }
__device__ __forceinline__ float bfhi(unsigned w) { return __builtin_bit_cast(float, w & 0xffff0000u); }
__device__ __forceinline__ float wave_sum(float v) {
#pragma unroll
    for (int o = 1; o < 64; o <<= 1) v += __shfl_xor(v, o);
    return v;
}

#define XB_TMO      128
#define XB_XCNT(j)  (256  + 64 * (j))
#define XB_XSUB(j)  (1280 + 64 * (j))
#define XB_XGEN(j)  (2304 + 64 * (j))
#define XB_TOP      3328
#define XB_TOPGEN   3392
#define XCD_BAR_WORDS 3456
#define XB_SPIN_CAP (1u << 24)
__device__ __forceinline__ unsigned xb_ld(unsigned* p)              { return __hip_atomic_load(p, __ATOMIC_RELAXED, __HIP_MEMORY_SCOPE_AGENT); }
__device__ __forceinline__ unsigned xb_add(unsigned* p, unsigned v) { return __hip_atomic_fetch_add(p, v, __ATOMIC_RELAXED, __HIP_MEMORY_SCOPE_AGENT); }
__device__ __forceinline__ unsigned xb_xcc_id() { return (unsigned)__builtin_amdgcn_s_getreg((3 << 11) | 20) & 0xFu; }
#define XB_SPIN(cond, bar) do { unsigned _sp = 0; while (cond) { __builtin_amdgcn_s_sleep(1); \
    if ((++_sp & 255u) == 0u) { if (xb_ld(&(bar)[XB_TMO])) break; if (_sp > XB_SPIN_CAP) { atomicAdd(&(bar)[XB_TMO], 1u); break; } } } } while (0)
struct XcdBarrier { unsigned* bar; unsigned x; volatile LAS unsigned* st; };
__device__ __forceinline__ XcdBarrier xcd_barrier_post(unsigned* bar, volatile LAS unsigned* st) {
    XcdBarrier b; b.bar = bar; b.x = xb_xcc_id(); b.st = st;
    if (threadIdx.x == 0) (void)xb_add(&bar[XB_XCNT(b.x)], 1u);
    return b;
}
__device__ __forceinline__ void xcd_barrier_complete(unsigned* bar, unsigned x, unsigned& nloc, unsigned& nx) {
    const unsigned G = gridDim.x * gridDim.y * gridDim.z;
    unsigned sum, cnt, mine, sp = 0u;
    for (;;) {
        sum = 0u; cnt = 0u; mine = 0u;
#pragma unroll
        for (unsigned j = 0; j < 16; ++j) { const unsigned c = xb_ld(&bar[XB_XCNT(j)]); sum += c; cnt += (c > 0u) ? 1u : 0u; mine = (j == x) ? c : mine; }
        if (sum == G) break;
        __builtin_amdgcn_s_sleep(1);
        if ((++sp & 255u) == 0u) { if (xb_ld(&bar[XB_TMO])) break; if (sp > XB_SPIN_CAP) { atomicAdd(&bar[XB_TMO], 1u); break; } }
    }
    nloc = mine > 0u ? mine : 1u; nx = cnt > 0u ? cnt : 1u;
}
__device__ __forceinline__ void xcd_barrier(const XcdBarrier& b) {
    asm volatile("s_waitcnt vmcnt(0)" ::: "memory");
    __syncthreads();
    if (threadIdx.x == 0) {
        unsigned* bar = b.bar;
        __builtin_amdgcn_s_waitcnt(0);
        unsigned nloc = b.st[0], nx = b.st[1];
        if (nloc == 0u) { xcd_barrier_complete(bar, b.x, nloc, nx); b.st[0] = nloc; b.st[1] = nx; }
        const unsigned old = xb_add(&bar[XB_XSUB(b.x)], 1u);
        const unsigned gen = old / nloc;
        if (old + 1u == (gen + 1u) * nloc) {
            __builtin_amdgcn_fence(__ATOMIC_RELEASE, "agent");
            asm volatile("s_waitcnt vmcnt(0)" ::: "memory");
            const unsigned og = xb_add(&bar[XB_TOP], 1u);
            const unsigned tg = og / nx;
            if (og + 1u == (tg + 1u) * nx) xb_add(&bar[XB_TOPGEN], 1u);
            else XB_SPIN(xb_ld(&bar[XB_TOPGEN]) == tg, bar);
            __builtin_amdgcn_fence(__ATOMIC_ACQUIRE, "agent");
            xb_add(&bar[XB_XGEN(b.x)], 1u);
            asm volatile("s_waitcnt vmcnt(0)" ::: "memory");
        } else {
            XB_SPIN(xb_ld(&bar[XB_XGEN(b.x)]) == gen, bar);
            __builtin_amdgcn_fence(__ATOMIC_ACQUIRE, "agent");
            asm volatile("s_waitcnt vmcnt(0)" ::: "memory");
        }
    }
    __syncthreads();
}

struct Args { const float* in[23]; float* out; unsigned char* ws; int ph_lo, ph_hi; };


struct TrDesc { const float* src; const float* gain; unsigned char* dst; int N, dpitch, k0, n0, mode, f8; float scale; };
constexpr int TR_HIN = 16 * 256, TR_HOUT = 16 * 64, TR_FG = 16 * 176, TR_FD = 44 * 64, TR_SIN = 16 * 128, TR_SOUT = 16 * 64, TR_MG = 16 * 224, TR_MD = 56 * 64;
constexpr int TR_NITEMS = TR_HIN + TR_HOUT + 2 * TR_FG + TR_FD + TR_SIN + TR_SOUT + 8 * (2 * TR_MG + TR_MD);
__device__ __forceinline__ void tr_set(TrDesc& d, const float* W, int K, int N, const float* gain, unsigned char* dst, int mode, int f8, float scale, int item) {
    const int nblk = N / 32, kb = item / nblk, nb = item - kb * nblk;
    d.src = W; d.gain = gain; d.dst = dst; d.N = N; d.dpitch = f8 ? K : 2 * K; d.k0 = 128 * kb; d.n0 = 32 * nb; d.mode = mode; d.f8 = f8; d.scale = scale;
}
__device__ __forceinline__ void tr_desc(const Args& a, int it, TrDesc& d) {
    unsigned char* ws = a.ws; int r = it;
    if (r < TR_HIN) { tr_set(d, a.in[3], 2048, 8192, a.in[2], ws + WS_W_HIN, 0, 2, I8_SW, r); return; } r -= TR_HIN;
    if (r < TR_HOUT) { tr_set(d, a.in[5], 2048, 2048, nullptr, ws + WS_W_HOUT, 0, 0, 1.f, r); return; } r -= TR_HOUT;
    if (r < TR_FG) { tr_set(d, a.in[7], 2048, DFF, a.in[6], ws + WS_W_FGU, 1, 2, I8_SW, r); return; } r -= TR_FG;
    if (r < TR_FG) { tr_set(d, a.in[8], 2048, DFF, a.in[6], ws + WS_W_FGU, 2, 2, I8_SW, r); return; } r -= TR_FG;
    if (r < TR_FD) { tr_set(d, a.in[9], DFF, 2048, nullptr, ws + WS_W_FD, 0, 0, 1.f, r); return; } r -= TR_FD;
    if (r < TR_SIN) { tr_set(d, a.in[11], 2048, 4096, a.in[10], ws + WS_W_SIN, 0, 2, I8_SW, r); return; } r -= TR_SIN;
    if (r < TR_SOUT) { tr_set(d, a.in[16], 2048, 2048, nullptr, ws + WS_W_SOUT, 0, 0, 1.f, r); return; } r -= TR_SOUT;
    if (r < 8 * TR_MG) { const int e = r / TR_MG; tr_set(d, a.in[19] + (size_t)e * 2048 * DFFE, 2048, DFFE, a.in[17], ws + WS_W_MGU + (size_t)e * 2 * DFFE * 2048, 1, 1, F8_SW_UP, r - e * TR_MG); return; } r -= 8 * TR_MG;
    if (r < 8 * TR_MG) { const int e = r / TR_MG; tr_set(d, a.in[20] + (size_t)e * 2048 * DFFE, 2048, DFFE, a.in[17], ws + WS_W_MGU + (size_t)e * 2 * DFFE * 2048, 2, 1, F8_SW_UP, r - e * TR_MG); return; } r -= 8 * TR_MG;
    { const int e = r / TR_MD; tr_set(d, a.in[21] + (size_t)e * DFFE * 2048, DFFE, 2048, nullptr, ws + WS_W_MD + (size_t)e * 2048 * DFFE, 0, 1, F8_SW_DN, r - e * TR_MD); }
}
__device__ __forceinline__ void tr_load(const TrDesc& d, f32x4 (&v)[16], float (&g)[16], int lane) {
    const int r = lane >> 3, c4 = lane & 7; const float* base = d.src + (size_t)(d.k0 + r) * d.N + d.n0 + 4 * c4; const size_t step = (size_t)8 * d.N;
#pragma unroll
    for (int i = 0; i < 16; ++i) v[i] = __builtin_nontemporal_load((const f32x4*)(base + i * step));
#pragma unroll
    for (int i = 0; i < 16; ++i) g[i] = d.gain ? d.gain[d.k0 + 8 * i + r] : 1.f;
}
__device__ __forceinline__ void tr_process(const TrDesc& d, const f32x4 (&v)[16], const float (&g)[16], LAS float* scr, int lane) {
    { const int r = lane >> 3, c4 = lane & 7;
#pragma unroll
      for (int i = 0; i < 16; ++i) { const float s = g[i] * d.scale; LAS float* p = scr + (8 * i + r) * 33 + 4 * c4; p[0] = v[i].x * s; p[1] = v[i].y * s; p[2] = v[i].z * s; p[3] = v[i].w * s; } }
    LDS_WAIT(); asm volatile("" ::: "memory");
    const int c = lane & 15, nn = lane >> 4;
#pragma unroll
    for (int t = 0; t < 8; ++t) { const int n = nn + 4 * t; const LAS float* s = scr + (8 * c) * 33 + n;
        const int gn = d.n0 + n; const int row = d.mode == 0 ? gn : (gn >> 7) * 256 + (d.mode - 1) * 128 + (gn & 127);
        unsigned char* o = d.dst + (size_t)row * d.dpitch;
        if (d.f8 == 2) { v2u w; w.x = pg8::pk4_i8(s[0 * 33], s[1 * 33], s[2 * 33], s[3 * 33]); w.y = pg8::pk4_i8(s[4 * 33], s[5 * 33], s[6 * 33], s[7 * 33]); *(v2u*)(o + d.k0 + 8 * c) = w; }
        else if (d.f8) { v2u w; w.x = pg8::pk4_fp8(s[0 * 33], s[1 * 33], s[2 * 33], s[3 * 33]); w.y = pg8::pk4_fp8(s[4 * 33], s[5 * 33], s[6 * 33], s[7 * 33]); *(v2u*)(o + d.k0 + 8 * c) = w; }
        else { v4u w; w.x = pk2(s[0 * 33], s[1 * 33]); w.y = pk2(s[2 * 33], s[3 * 33]); w.z = pk2(s[4 * 33], s[5 * 33]); w.w = pk2(s[6 * 33], s[7 * 33]); *(v4u*)(o + 2 * (d.k0 + 8 * c)) = w; } }
    asm volatile("" ::: "memory");
}

__device__ __forceinline__ void p0_prologue(const Args& a, LAS unsigned char* lds, int vcu, int G, int wave, int lane) {
    unsigned char* ws = a.ws;
    LAS float* scr = (LAS float*)(lds + wave * 16896);
    const int gw = vcu * NWAVES + wave, NGW = G * NWAVES;
    { const float* x = a.in[0]; unsigned char* xq = ws + WS_R + 128 * MiB;
      for (int m = gw; m < M; m += NGW) {
          const f32x4* xr = (const f32x4*)(x + (size_t)m * D) + lane; f32x4 v[8]; float s = 0.f;
#pragma unroll
          for (int j = 0; j < 8; ++j) { v[j] = xr[64 * j]; s += (v[j].x * v[j].x + v[j].y * v[j].y) + (v[j].z * v[j].z + v[j].w * v[j].w); }
          const float sc = I8_SA / sqrtf(wave_sum(s) * (1.0f / 2048.0f) + EPS);
          unsigned* o = (unsigned*)(xq + (size_t)m * D) + lane;
#pragma unroll
          for (int j = 0; j < 8; ++j) o[64 * j] = pg8::pk4_i8(v[j].x * sc, v[j].y * sc, v[j].z * sc, v[j].w * sc); } }
    { const float* lg = a.in[1]; float* lb = (float*)(ws + WS_LB);
      for (int c = gw * 64 + lane; c < 2048; c += NGW * 64) { const float l0 = lg[c], l1 = lg[2048 + c], l2 = lg[4096 + c], mx = fmaxf(l0, fmaxf(l1, l2));
          const float e0 = __expf(l0 - mx), e1 = __expf(l1 - mx), e2 = __expf(l2 - mx); lb[c] = e0 / (e0 + e1 + e2); }
      int* rt = (int*)(ws + WS_ROWTOK); float* rw = (float*)(ws + WS_ROWW); float* rr = (float*)(ws + WS_ROWRS);
      for (int i = gw * 64 + lane; i < 2 * SROWS; i += NGW * 64) { rt[i] = -1; rw[i] = 0.f; rr[i] = 0.f; } }
    TrDesc cur, nxt; f32x4 cv[16], nv[16]; float cg[16], ng[16];
    int it = gw; bool have = it < TR_NITEMS;
    if (have) { tr_desc(a, it, cur); tr_load(cur, cv, cg, lane); }
    while (have) {
        const int itn = it + NGW; const bool hn = itn < TR_NITEMS;
        if (hn) { tr_desc(a, itn, nxt); tr_load(nxt, nv, ng, lane); }
        tr_process(cur, cv, cg, scr, lane);
        cur = nxt; it = itn; have = hn;
#pragma unroll
        for (int i = 0; i < 16; ++i) { cv[i] = nv[i]; cg[i] = ng[i]; }
    }
}

#define MFMA32(a, b, c) __builtin_amdgcn_mfma_f32_32x32x16_bf16((a), (b), (c), 0, 0, 0)
template <int KSTEPS> __device__ __forceinline__ void mma_img(f32x16& acc, const LAS unsigned char* A, int pa, int m0, const LAS unsigned char* B, int pb, int n0, int lane) {
    const int r = lane & 31, h = lane >> 5; const LAS unsigned char* ap = A + (m0 + r) * pa + 16 * h; const LAS unsigned char* bp = B + (n0 + r) * pb + 16 * h;
#pragma unroll
    for (int s = 0; s < KSTEPS; ++s) { const bf16x8 av = *(const LAS bf16x8*)(ap + 32 * s), bv = *(const LAS bf16x8*)(bp + 32 * s); acc = MFMA32(av, bv, acc); }
}
constexpr int SC_P128 = 272, SC_P64 = 144;
constexpr int SC_KI = 0, SC_QI = 17408, SC_QE = 34816, SC_ST = 52224, SC_VT = 87040, SC_KST = 105472, SC_P = 123904, SC_DEC = 133120, SC_CSUM = 133632  , SC_RED = 137728, SC_NG = 138752, SC_END = 139264;
static_assert(SC_END <= MISC_OFF, "scan LDS");

__device__ __forceinline__ void hgrn_scan_unit(LAS unsigned char* lds, int bh, const bf16* Qg, const bf16* Kg, const bf16* Gg, const bf16* Ig, const bf16* Gtg, bf16* Og, const float* normg, int tid) {
    const int lane = tid & 63, wave = tid >> 6, b = bh >> 4, hh = bh & 15;
    const int r = lane & 31, h2 = lane >> 5;
    const size_t gbase = (size_t)b * SEQ * 2048 + hh * 128;
    for (int i = tid; i < 34816 / 16; i += 512) *(LAS v4u*)(lds + SC_ST + 16 * i) = (v4u){0u, 0u, 0u, 0u};
    if (tid < 128) ((LAS float*)(lds + SC_NG))[tid] = normg[hh * 128 + tid];
    f32x16 S0, S1;
#pragma unroll
    for (int i = 0; i < 16; ++i) { S0[i] = 0.f; S1[i] = 0.f; }
    const int dkp = tid & 63, dk0 = 2 * dkp, tq8 = wave;
    unsigned cq[8], cg[8], cv[8];
    { const size_t o = gbase + (size_t)(8 * tq8) * 2048 + dk0;
#pragma unroll
      for (int i = 0; i < 8; ++i) { cq[i] = *(const unsigned*)(Qg + o + (size_t)i * 2048); cg[i] = *(const unsigned*)(Gg + o + (size_t)i * 2048); cv[i] = *(const unsigned*)(Ig + o + (size_t)i * 2048); } }
    WG_BAR();
    for (int c = 0; c < NCH; ++c) {
        unsigned nq[8], ng[8], nv[8];
        { const int cn = (c + 1 < NCH) ? c + 1 : c; const size_t o = gbase + (size_t)(64 * cn + 8 * tq8) * 2048 + dk0;
#pragma unroll
          for (int i = 0; i < 8; ++i) { nq[i] = *(const unsigned*)(Qg + o + (size_t)i * 2048); ng[i] = *(const unsigned*)(Gg + o + (size_t)i * 2048); nv[i] = *(const unsigned*)(Ig + o + (size_t)i * 2048); } }
        v2u gtv[4];
        { const size_t orow_ = gbase + (size_t)(64 * c + 32 * (wave & 1) + r) * 2048 + 32 * (wave >> 1) + 4 * h2;
#pragma unroll
          for (int g4 = 0; g4 < 4; ++g4) gtv[g4] = *(const v2u*)(Gtg + orow_ + 8 * g4); }
        float bl0[8], bl1[8]; { float r0 = 0.f, r1 = 0.f;
#pragma unroll
          for (int i = 0; i < 8; ++i) { r0 += bflo(cg[i]); r1 += bfhi(cg[i]); bl0[i] = r0; bl1[i] = r1; }
          *(LAS pg8::f32x2*)(lds + SC_CSUM + 4 * (tq8 * 128 + dk0)) = (pg8::f32x2){r0, r1}; }
        WG_BAR();
        { float pre0 = 0.f, pre1 = 0.f, mid0 = 0.f, mid1 = 0.f, tot0 = 0.f, tot1 = 0.f;
#pragma unroll
          for (int q8 = 0; q8 < 8; ++q8) { const pg8::f32x2 cs = *(const LAS pg8::f32x2*)(lds + SC_CSUM + 4 * (q8 * 128 + dk0));
              if (q8 < tq8) { pre0 += cs.x; pre1 += cs.y; } if (q8 < 4) { mid0 += cs.x; mid1 += cs.y; } tot0 += cs.x; tot1 += cs.y; }
          const float A10 = __expf(-mid0), A11 = __expf(-mid1), A20 = __expf(mid0), A21 = __expf(mid1), Dc0 = __expf(tot0), Dc1 = __expf(tot1);
          if (tq8 == 0) *(LAS pg8::f32x2*)(lds + SC_DEC + 4 * dk0) = (pg8::f32x2){Dc0, Dc1};
          float ks0[8], ks1[8];
#pragma unroll
          for (int i = 0; i < 8; ++i) {
              const int t = 8 * tq8 + i;
              const float E0 = __expf(fmaxf(pre0 + bl0[i], -80.f)), E1 = __expf(fmaxf(pre1 + bl1[i], -80.f)), rE0 = __builtin_amdgcn_rcpf(E0), rE1 = __builtin_amdgcn_rcpf(E1);
              const float q0 = bflo(cq[i]), q1 = bfhi(cq[i]), k0 = 1.0f - __expf(bflo(cg[i])), k1 = 1.0f - __expf(bfhi(cg[i]));
              const float qe0 = q0 * E0, qe1 = q1 * E1, kr0 = k0 * rE0, kr1 = k1 * rE1;
              *(LAS unsigned*)(lds + SC_QI + t * SC_P128 + 4 * dkp) = pk2(qe0 * A10, qe1 * A11);
              *(LAS unsigned*)(lds + SC_KI + t * SC_P128 + 4 * dkp) = pk2(kr0 * A20, kr1 * A21);
              *(LAS unsigned*)(lds + SC_QE + t * SC_P128 + 4 * dkp) = pk2(qe0, qe1);
              ks0[i] = kr0 * Dc0; ks1[i] = kr1 * Dc1; }
          *(LAS v4u*)(lds + SC_KST + dk0 * SC_P64 + 16 * tq8) = (v4u){pk2(ks0[0], ks0[1]), pk2(ks0[2], ks0[3]), pk2(ks0[4], ks0[5]), pk2(ks0[6], ks0[7])};
          *(LAS v4u*)(lds + SC_KST + (dk0 + 1) * SC_P64 + 16 * tq8) = (v4u){pk2(ks1[0], ks1[1]), pk2(ks1[2], ks1[3]), pk2(ks1[4], ks1[5]), pk2(ks1[6], ks1[7])};
          *(LAS v4u*)(lds + SC_VT + dk0 * SC_P64 + 16 * tq8) = (v4u){(cv[0] & 0xffffu) | (cv[1] << 16), (cv[2] & 0xffffu) | (cv[3] << 16), (cv[4] & 0xffffu) | (cv[5] << 16), (cv[6] & 0xffffu) | (cv[7] << 16)};
          *(LAS v4u*)(lds + SC_VT + (dk0 + 1) * SC_P64 + 16 * tq8) = (v4u){(cv[0] >> 16) | (cv[1] & 0xffff0000u), (cv[2] >> 16) | (cv[3] & 0xffff0000u), (cv[4] >> 16) | (cv[5] & 0xffff0000u), (cv[6] >> 16) | (cv[7] & 0xffff0000u)}; }
        WG_BAR();
        const int dm = wave >> 1, tn = wave & 1;
        f32x16 oacc;
#pragma unroll
        for (int i = 0; i < 16; ++i) oacc[i] = 0.f;
        mma_img<8>(oacc, lds + SC_ST, SC_P128, 32 * dm, lds + SC_QE, SC_P128, 32 * tn, lane);
        if (wave < 4) {
            const int sm = wave >> 1, xn = wave & 1; f32x16 x;
#pragma unroll
            for (int i = 0; i < 16; ++i) x[i] = 0.f;
            mma_img<8>(x, lds + SC_KI, SC_P128, 32 * sm, lds + SC_QI, SC_P128, 32 * xn, lane);
            const int t = 32 * xn + r;
#pragma unroll
            for (int g4 = 0; g4 < 4; ++g4) { const int s0 = 32 * sm + 8 * g4 + 4 * h2; float v[4];
#pragma unroll
                for (int j = 0; j < 4; ++j) v[j] = (t >= s0 + j) ? x[4 * g4 + j] : 0.f;
                *(LAS v2u*)(lds + SC_P + t * SC_P64 + 2 * s0) = (v2u){pk2(v[0], v[1]), pk2(v[2], v[3])}; }
        }
        WG_BAR();
        mma_img<4>(oacc, lds + SC_VT, SC_P64, 32 * dm, lds + SC_P, SC_P64, 32 * tn, lane);
        { const int km = wave >> 1, vn0 = 2 * (wave & 1);
#pragma unroll
          for (int g4 = 0; g4 < 4; ++g4) { const f32x4 dc = *(const LAS f32x4*)(lds + SC_DEC + 4 * (32 * km + 8 * g4 + 4 * h2));
#pragma unroll
              for (int j = 0; j < 4; ++j) { S0[4 * g4 + j] *= dc[j]; S1[4 * g4 + j] *= dc[j]; } }
          mma_img<4>(S0, lds + SC_KST, SC_P64, 32 * km, lds + SC_VT, SC_P64, 32 * vn0, lane);
          mma_img<4>(S1, lds + SC_KST, SC_P64, 32 * km, lds + SC_VT, SC_P64, 32 * (vn0 + 1), lane); }
        { float ss = 0.f;
#pragma unroll
          for (int i = 0; i < 16; ++i) ss += oacc[i] * oacc[i];
          ss += __shfl_xor(ss, 32);
          if (h2 == 0) ((LAS float*)(lds + SC_RED))[dm * 64 + 32 * tn + r] = ss; }
        WG_BAR();
        { const int km = wave >> 1, vn0 = 2 * (wave & 1);
#pragma unroll
          for (int g4 = 0; g4 < 4; ++g4) { const int dk0 = 32 * km + 8 * g4 + 4 * h2;
              *(LAS v2u*)(lds + SC_ST + (32 * vn0 + r) * SC_P128 + 2 * dk0) = (v2u){pk2(S0[4 * g4], S0[4 * g4 + 1]), pk2(S0[4 * g4 + 2], S0[4 * g4 + 3])};
              *(LAS v2u*)(lds + SC_ST + (32 * (vn0 + 1) + r) * SC_P128 + 2 * dk0) = (v2u){pk2(S1[4 * g4], S1[4 * g4 + 1]), pk2(S1[4 * g4 + 2], S1[4 * g4 + 3])}; } }
        { const int t = 32 * tn + r; const LAS float* rd = (const LAS float*)(lds + SC_RED);
          const float tot = (rd[t] + rd[64 + t]) + (rd[128 + t] + rd[192 + t]), rinv = 1.0f / sqrtf(tot * (1.0f / 128.0f) + EPS);
          const size_t orow = gbase + (size_t)(64 * c + t) * 2048;
#pragma unroll
          for (int g4 = 0; g4 < 4; ++g4) { const int dv0 = 32 * dm + 8 * g4 + 4 * h2;
              const f32x4 ng4 = *(const LAS f32x4*)(lds + SC_NG + 4 * dv0); const v2u gt = gtv[g4];
              const float o0 = oacc[4 * g4] * rinv * ng4[0] * bflo(gt.x), o1 = oacc[4 * g4 + 1] * rinv * ng4[1] * bfhi(gt.x), o2 = oacc[4 * g4 + 2] * rinv * ng4[2] * bflo(gt.y), o3 = oacc[4 * g4 + 3] * rinv * ng4[3] * bfhi(gt.y);
              *(v2u*)(Og + orow + dv0) = (v2u){pk2(o0, o1), pk2(o2, o3)}; } }
#pragma unroll
        for (int i = 0; i < 8; ++i) { cq[i] = nq[i]; cg[i] = ng[i]; cv[i] = nv[i]; }
        WG_BAR();
    }
}

constexpr int SG_WM = 0, SG_VT = 34816, SG_MR = 69632, SG_END = 70656;
__device__ __forceinline__ void sgu_load_wm(LAS unsigned char* lds, const float* ws_g, int tid) {
    for (int i = tid; i < 128 * 32; i += 512) { const int t = i >> 5, s4 = (i & 31) * 4; f32x4 w = *(const f32x4*)(ws_g + t * 128 + s4);
        if (t < 64 && s4 >= 64) w = (f32x4){0.f, 0.f, 0.f, 0.f};
        *(LAS v2u*)(lds + SG_WM + t * SC_P128 + 2 * s4) = (v2u){pk2(w[0], w[1]), pk2(w[2], w[3])}; }
}
struct SguPre { unsigned raw[16]; float s1, s2; };
__device__ __forceinline__ void sgu_load(const bf16* V, const pg8::u64* stats, int bn, int g, int tid, SguPre& p) {
    const int cp = tid & 63, sq = tid >> 6; const bf16* vp = V + ((size_t)bn * 128 + 16 * sq) * 2048 + 128 * g + 2 * cp;
#pragma unroll
    for (int i = 0; i < 16; ++i) p.raw[i] = *(const unsigned*)(vp + (size_t)i * 2048);
    p.s1 = 0.f; p.s2 = 0.f;
    if (tid < 128) { p.s1 = pg8::fx_get(stats + 2 * ((size_t)bn * 128 + tid)); p.s2 = pg8::fx_get(stats + 2 * ((size_t)bn * 128 + tid) + 1); }
}
__device__ __forceinline__ void sgu_unit(LAS unsigned char* lds, int bn, int g, const bf16* U, bf16* Uo, const SguPre& cur, const bf16* V, const pg8::u64* stats, int nbn, int ng, SguPre& nxt,
                                         pg8::f32x2 gg, pg8::f32x2 bb, float bias0, float bias1, int tid) {
    const int lane = tid & 63, wave = tid >> 6, r = lane & 31, h2 = lane >> 5;
    const size_t row0 = (size_t)bn * 128;
    if (tid < 128) { const float mean = cur.s1 * (1.0f / 2048.0f), var = fmaxf(cur.s2 * (1.0f / 2048.0f) - mean * mean, 0.f);
        ((LAS float*)(lds + SG_MR))[2 * tid] = mean; ((LAS float*)(lds + SG_MR))[2 * tid + 1] = 1.0f / sqrtf(var + EPS); }
    WG_BAR();
    { const int cp = tid & 63, sq = tid >> 6, c0 = 2 * cp;
      unsigned pk0[8], pk1[8];
#pragma unroll
      for (int i = 0; i < 16; i += 2) { const int s = 16 * sq + i; const pg8::f32x4 mr = *(const LAS pg8::f32x4*)(lds + SG_MR + 8 * s);
          const float a0 = (bflo(cur.raw[i]) - mr[0]) * mr[1] * gg.x + bb.x, a1 = (bflo(cur.raw[i + 1]) - mr[2]) * mr[3] * gg.x + bb.x;
          const float b0 = (bfhi(cur.raw[i]) - mr[0]) * mr[1] * gg.y + bb.y, b1 = (bfhi(cur.raw[i + 1]) - mr[2]) * mr[3] * gg.y + bb.y;
          pk0[i >> 1] = pk2(a0, a1); pk1[i >> 1] = pk2(b0, b1); }
      *(LAS v4u*)(lds + SG_VT + c0 * SC_P128 + 32 * sq) = (v4u){pk0[0], pk0[1], pk0[2], pk0[3]};
      *(LAS v4u*)(lds + SG_VT + c0 * SC_P128 + 32 * sq + 16) = (v4u){pk0[4], pk0[5], pk0[6], pk0[7]};
      *(LAS v4u*)(lds + SG_VT + (c0 + 1) * SC_P128 + 32 * sq) = (v4u){pk1[0], pk1[1], pk1[2], pk1[3]};
      *(LAS v4u*)(lds + SG_VT + (c0 + 1) * SC_P128 + 32 * sq + 16) = (v4u){pk1[4], pk1[5], pk1[6], pk1[7]}; }
    WG_BAR();
    sgu_load(V, stats, nbn, ng, tid, nxt);
    const int cm = wave >> 1;
#pragma unroll
    for (int jj = 0; jj < 2; ++jj) { const int tn = 2 * (wave & 1) + jj; f32x16 acc;
#pragma unroll
        for (int i = 0; i < 16; ++i) acc[i] = 0.f;
        mma_img<8>(acc, lds + SG_VT, SC_P128, 32 * cm, lds + SG_WM, SC_P128, 32 * tn, lane);
        const int t = 32 * tn + r; const float bias = jj ? bias1 : bias0; const bf16* up = U + (row0 + t) * 2048 + 128 * g; bf16* uo = Uo + (row0 + t) * 2048 + 128 * g;
#pragma unroll
        for (int g4 = 0; g4 < 4; ++g4) { const int c0 = 32 * cm + 8 * g4 + 4 * h2; const v2u uu = *(const v2u*)(up + c0);
            const float o0 = (acc[4 * g4] + bias) * bflo(uu.x), o1 = (acc[4 * g4 + 1] + bias) * bfhi(uu.x), o2 = (acc[4 * g4 + 2] + bias) * bflo(uu.y), o3 = (acc[4 * g4 + 3] + bias) * bfhi(uu.y);
            *(v2u*)(uo + c0) = (v2u){pk2(o0, o1), pk2(o2, o3)}; } }
    WG_BAR();
}

constexpr int RT_W = 0, RT_LCNT = 65536, RT_BASE = RT_LCNT + 64, RT_E = RT_BASE + 64, RT_LP = RT_E + 1024, RT_END = RT_LP + 1024;
__device__ __forceinline__ void router_phase(const Args& a, LAS unsigned char* lds, int G, int tid) {
    unsigned char* ws = a.ws; const int lane = tid & 63, wave = tid >> 6;
    const bf16* x2 = (const bf16*)(ws + WS_XB);     unsigned char* xb8 = ws + WS_R + R_H;     const float* gain = a.in[17]; const float* wr = a.in[18];
    unsigned* gcnt = (unsigned*)(ws + WS_CTL) + CW_CNT;
    int* tok_e = (int*)(ws + WS_TOKE); int* tok_p = (int*)(ws + WS_TOKP); float* tok_w = (float*)(ws + WS_TOKW); float* tok_rs = (float*)(ws + WS_TOKRS);
    LAS float* wrT = (LAS float*)(lds + RT_W); LAS int* lcnt = (LAS int*)(lds + RT_LCNT); LAS int* lbase = (LAS int*)(lds + RT_BASE); LAS int* le = (LAS int*)(lds + RT_E); LAS int* lp = (LAS int*)(lds + RT_LP);
    for (int i = tid; i < 2048 * 8; i += 512) { const int k = i >> 3, e = i & 7; wrT[e * 2048 + k] = wr[i] * gain[k]; }
    if (tid < 16) lcnt[tid] = 0;
    WG_BAR();
    for (int t0 = blockIdx.x * 128; t0 < M; t0 += G * 128) {
        v2u nx[8];
        { const int t = t0 + wave * 16; const v2u* xr = (const v2u*)(x2 + (size_t)t * D) + lane;
#pragma unroll
          for (int jj = 0; jj < 8; ++jj) nx[jj] = xr[64 * jj]; }
        for (int j = 0; j < 16; ++j) {
            const int ti = wave * 16 + j, t = t0 + ti;
            float acc[8], ss = 0.f; f32x4 xa[8];
#pragma unroll
            for (int jj = 0; jj < 8; ++jj) { const v2u xq = nx[jj]; xa[jj] = (f32x4){bflo(xq.x), bfhi(xq.x), bflo(xq.y), bfhi(xq.y)}; }
            { const int tn = t0 + wave * 16 + (j < 15 ? j + 1 : j); const v2u* xr = (const v2u*)(x2 + (size_t)tn * D) + lane;
#pragma unroll
              for (int jj = 0; jj < 8; ++jj) nx[jj] = xr[64 * jj]; }
#pragma unroll
            for (int e = 0; e < 8; ++e) acc[e] = 0.f;
#pragma unroll
            for (int jj = 0; jj < 8; ++jj) { const f32x4 xv = xa[jj]; ss += (xv.x * xv.x + xv.y * xv.y) + (xv.z * xv.z + xv.w * xv.w);
#pragma unroll
                for (int e = 0; e < 8; ++e) { const f32x4 w4 = *(const LAS f32x4*)(wrT + e * 2048 + 4 * lane + 256 * jj); acc[e] += (xv.x * w4.x + xv.y * w4.y) + (xv.z * w4.z + xv.w * w4.w); } }
            ss = wave_sum(ss);
#pragma unroll
            for (int e = 0; e < 8; ++e) acc[e] = wave_sum(acc[e]);
            const float rs = 1.0f / sqrtf(ss * (1.0f / 2048.0f) + EPS);
            { const float sc = rs * F8_SA; unsigned* dst = (unsigned*)(xb8 + (size_t)t * D) + lane;
#pragma unroll
              for (int jj = 0; jj < 8; ++jj) dst[64 * jj] = pg8::pk4_fp8(xa[jj].x * sc, xa[jj].y * sc, xa[jj].z * sc, xa[jj].w * sc); }
            float v1 = -3.0e38f, v2 = -3.0e38f; int i1 = 0, i2 = 0;
#pragma unroll
            for (int e = 0; e < 8; ++e) { const float l = acc[e] * rs; if (l > v1) { v2 = v1; i2 = i1; v1 = l; i1 = e; } else if (l > v2) { v2 = l; i2 = e; } }
            if (lane == 0) {
                const float ex = __expf(v2 - v1), w1 = 1.0f / (1.0f + ex), w2 = ex * w1;
                tok_w[t] = w1; tok_w[M + t] = w2; tok_rs[t] = rs;
                le[ti] = i1; le[128 + ti] = i2;
                lp[ti] = __hip_atomic_fetch_add(lcnt + i1, 1, __ATOMIC_RELAXED, __HIP_MEMORY_SCOPE_WORKGROUP);
                lp[128 + ti] = __hip_atomic_fetch_add(lcnt + 8 + i2, 1, __ATOMIC_RELAXED, __HIP_MEMORY_SCOPE_WORKGROUP);
            }
        }
        WG_BAR();
        if (tid < 16) { lbase[tid] = (int)__hip_atomic_fetch_add(gcnt + 64 * tid, (unsigned)lcnt[tid], __ATOMIC_RELAXED, __HIP_MEMORY_SCOPE_AGENT); lcnt[tid] = 0; }
        WG_BAR();
        if (tid < 256) { const int k = tid >> 7, ti = tid & 127, e = le[k * 128 + ti]; tok_e[k * M + t0 + ti] = e; tok_p[k * M + t0 + ti] = lbase[8 * k + e] + lp[k * 128 + ti]; }
        WG_BAR();
    }
}
__device__ __forceinline__ void moe_offsets(const Args& a, volatile LAS int* off, volatile LAS int* npan, int tid) {
    if (tid == 0) { const unsigned* gcnt = (const unsigned*)(a.ws + WS_CTL) + CW_CNT; int o = 0;
        for (int e = 0; e < 8; ++e) { const int n0 = (int)__hip_atomic_load(gcnt + 64 * e, __ATOMIC_RELAXED, __HIP_MEMORY_SCOPE_AGENT), n1 = (int)__hip_atomic_load(gcnt + 64 * (8 + e), __ATOMIC_RELAXED, __HIP_MEMORY_SCOPE_AGENT);
            off[16 + e] = o; off[e] = o; off[8 + e] = o + n0; o += ((n0 + n1 + 255) >> 8) << 8; }
        npan[0] = 0; npan[1] = o >> 8; }
    WG_BAR();
}
__device__ __forceinline__ void assign_phase(const Args& a, volatile LAS int* off, volatile LAS int* npan, int vcu, int G, int tid) {
    unsigned char* ws = a.ws; const int lane = tid & 63, wave = tid >> 6;
    moe_offsets(a, off, npan, tid);
    if (blockIdx.x == 0 && tid < 320) { const int p = tid; int* pe = (int*)(ws + WS_PANE);
        if (p < npan[1]) { int j = 0; for (int q = 1; q < 8; ++q) if (p * 256 >= off[16 + q]) j = q; pe[p] = j; }
        if (p == 0) ((int*)(ws + WS_NPAN))[0] = npan[1]; }
    const int* tok_e = (const int*)(ws + WS_TOKE); const int* tok_p = (const int*)(ws + WS_TOKP); const float* tok_w = (const float*)(ws + WS_TOKW);
    int* row_tok = (int*)(ws + WS_ROWTOK); float* row_w = (float*)(ws + WS_ROWW);
    const unsigned char* xb8 = ws + WS_R + R_H; unsigned char* AS = ws + WS_R + R_AS;
    const int gw = vcu * NWAVES + wave, NGW = G * NWAVES;
    for (int t = gw; t < M; t += NGW) {
        const v4u* src = (const v4u*)(xb8 + (size_t)t * D) + lane; const v4u q0 = src[0], q1 = src[64];
#pragma unroll
        for (int k = 0; k < 2; ++k) { const int e = tok_e[k * M + t], p = off[8 * k + e] + tok_p[k * M + t];
            if (lane == 0) { __hip_atomic_store(row_tok + p, k * M + t, __ATOMIC_RELAXED, __HIP_MEMORY_SCOPE_AGENT); __hip_atomic_store(row_w + p, tok_w[k * M + t], __ATOMIC_RELAXED, __HIP_MEMORY_SCOPE_AGENT); }
            v4u* dst = (v4u*)(AS + (size_t)p * D) + lane; dst[0] = q0; dst[64] = q1; }
    }
}

__device__ __forceinline__ Args ldargs() {
#if defined(__HIP_DEVICE_COMPILE__)
    const __attribute__((address_space(4))) unsigned char* p = (const __attribute__((address_space(4))) unsigned char*)__builtin_amdgcn_kernarg_segment_ptr(); asm volatile("" : "+s"(p));
    Args a; __builtin_memcpy(&a, (const unsigned char*)p, sizeof(Args)); return a;
#else
    return Args{};
#endif
}
__global__ void __launch_bounds__(NWAVES * 64, 2) trunk_fwd(Args kargs) {
    extern __shared__ __attribute__((aligned(16))) unsigned char lds_raw[];
    LAS unsigned char* lds = (LAS unsigned char*)lds_raw;
    volatile LAS unsigned* MISC = (volatile LAS unsigned*)(lds + MISC_OFF);
    const int wave = __builtin_amdgcn_readfirstlane((int)threadIdx.x >> 6);
#define LANE() ((int)__builtin_amdgcn_mbcnt_hi(~0u, __builtin_amdgcn_mbcnt_lo(~0u, 0u)))
#define TIDX() (wave * 64 + LANE())
    const int G = gridDim.x; const int bx = blockIdx.x; const int vcu = (G % 8 == 0) ? (bx % 8) * (G / 8) + bx / 8 : bx;
    unsigned char* ws = kargs.ws;
    unsigned* ctl = (unsigned*)(ws + WS_CTL);
    if (threadIdx.x < 64) MISC[threadIdx.x] = 0u;
    __syncthreads();
    XcdBarrier bar; bar.bar = ctl + CW_BAR; bar.x = 0; bar.st = nullptr;
#if !MK_PER_PHASE
    bar = xcd_barrier_post(ctl + CW_BAR, MISC + 8);
#define GRID_BAR() xcd_barrier(bar)
#else
#define GRID_BAR() do { } while (0)
#endif
    const int lo = kargs.ph_lo, hi = kargs.ph_hi;
#ifndef PH_MASK
#define PH_MASK 0xFFFF
#endif
#define IN(k) ((((PH_MASK) >> (k)) & 1) && lo <= (k) && (k) < hi)
#define BOTH(k) (IN(k) && IN((k) + 1))
    using namespace pg8;
    bf16* xb = (bf16*)(ws + WS_XB);
    float* out = kargs.out;

#ifndef PROBE
#define PROBE 0
#endif
#define REPS(k) _Pragma("nounroll") for (int rep = ((PROBE >> (k)) & 1) ? 0 : 1; rep < 2; ++rep)
    if (IN(0)) { const Args args = ldargs(); REPS(0) { p0_prologue(args, lds, vcu, G, wave, LANE()); if (BOTH(0)) GRID_BAR(); } }

    if (IN(1)) {
        Gemm g{(const bf16*)(ws + WS_R + 128 * MiB), (const bf16*)(ws + WS_W_HIN), M, 8192, 1024, 0}; StaticOrder S; S.init(M, 8192, G, bx);
        EpiHgrnIn E{1.0f / (I8_SA * I8_SW), (const float*)(ws + WS_LB), (bf16*)(ws + WS_R + R_Q), (bf16*)(ws + WS_R + R_G), (bf16*)(ws + WS_R + R_I), (bf16*)(ws + WS_R + R_GT)};
        REPS(1) { gemm_phase<EpiHgrnIn, StaticOrder, true, true, false, true>(lds, g, S, E, wave);
        if (BOTH(1)) GRID_BAR(); }
    }
    if (IN(2)) {
        const Args args = ldargs();
        REPS(2) { for (int bh = bx; bh < BATCH * NH; bh += G)
            hgrn_scan_unit(lds, bh, (const bf16*)(ws + WS_R + R_Q), (const bf16*)(ws + WS_R + R_K), (const bf16*)(ws + WS_R + R_G), (const bf16*)(ws + WS_R + R_I), (const bf16*)(ws + WS_R + R_GT), (bf16*)(ws + WS_O), args.in[4], TIDX());
        if (BOTH(2)) GRID_BAR(); }
    }
    if (IN(3)) {
        const Args args = ldargs();
        Gemm g{(const bf16*)(ws + WS_O), (const bf16*)(ws + WS_W_HOUT), M, 2048, 2048, 0}; StaticOrder S; S.init(M, 2048, G, bx);
        REPS(3) { EpiResid<false, false> E{args.in[0], nullptr, nullptr, rep ? xb : (bf16*)(ws + WS_R + 384 * MiB), (u64*)(rep ? ws + WS_RSS1 : ws + WS_R + 512 * MiB), ws + WS_R + 640 * MiB, I8_SA_X1};
        gemm_phase<EpiResid<false, false>, StaticOrder, true, true>(lds, g, S, E, wave);
        if (BOTH(3)) GRID_BAR(); }
    }
    if (IN(4)) {
        Gemm g{(const bf16*)(ws + WS_R + 640 * MiB), (const bf16*)(ws + WS_W_FGU), M, 2 * DFF, 1024, 0}; StaticOrder S; S.init(M, 2 * DFF, G, bx);
        EpiSwigluI<true, false> E{(void*)(ws + WS_R + R_HFF), DFF, 1.0f / (I8_SA_X1 * I8_SW), 1.f, (const u64*)(ws + WS_RSS1)};
        REPS(4) { gemm_phase<EpiSwigluI<true, false>, StaticOrder, true, true, false, true>(lds, g, S, E, wave);
        if (BOTH(4)) GRID_BAR(); }
    }
    if (IN(5)) {
        Gemm g{(const bf16*)(ws + WS_R + R_HFF), (const bf16*)(ws + WS_W_FD), M, 2048, DFF, 0}; StaticOrder S; S.init(M, 2048, G, bx);
        REPS(5) { EpiResidB16 E{xb, rep ? xb : (bf16*)(ws + WS_R + 608 * MiB), (u64*)(rep ? ws + WS_RSS2 : ws + WS_R + 736 * MiB), ws + WS_R + 640 * MiB, I8_SA_X2};
        gemm_phase<EpiResidB16, StaticOrder, true, true>(lds, g, S, E, wave);
        if (BOTH(5)) GRID_BAR(); }
    }
    if (IN(6)) {
        Gemm g{(const bf16*)(ws + WS_R + 640 * MiB), (const bf16*)(ws + WS_W_SIN), M, 4096, 1024, 0}; StaticOrder S; S.init(M, 4096, G, bx);
        REPS(6) { EpiSguIn E{(const u64*)(ws + WS_RSS2), (bf16*)(ws + WS_R + (rep ? R_U : 256 * MiB)), (bf16*)(ws + WS_R + (rep ? R_V : 384 * MiB)), (u64*)(rep ? ws + WS_LNST : ws + WS_R + 512 * MiB), 1.0f / (I8_SA_X2 * I8_SW)};
        gemm_phase<EpiSguIn, StaticOrder, true, true, false, true>(lds, g, S, E, wave);
        if (BOTH(6)) GRID_BAR(); }
    }
    if (IN(7)) {
        const Args args = ldargs();
        int last_g = -1; const int tid = TIDX();
        REPS(7) { SguPre cur, nxt; const int NU = (M / 128) * 16; pg8::f32x2 gg = {0.f, 0.f}, bb = {0.f, 0.f}; float bias0 = 0.f, bias1 = 0.f;
            if (bx < NU) sgu_load((const bf16*)(ws + WS_R + R_V), (const u64*)(ws + WS_LNST), bx >> 4, bx & 15, tid, cur);
            for (int u = bx; u < NU; u += G) { const int g = u & 15, bn = u >> 4;
            if (g != last_g) { sgu_load_wm(lds, args.in[14] + (size_t)g * 128 * 128, tid); last_g = g;
                gg = *(const pg8::f32x2*)(args.in[12] + 128 * g + 2 * (tid & 63)); bb = *(const pg8::f32x2*)(args.in[13] + 128 * g + 2 * (tid & 63));
                bias0 = args.in[15][g * 128 + 32 * (2 * ((tid >> 6) & 1)) + (tid & 31)]; bias1 = args.in[15][g * 128 + 32 * (2 * ((tid >> 6) & 1) + 1) + (tid & 31)]; }
            const int un = (u + G < NU) ? u + G : u;
            sgu_unit(lds, bn, g, (const bf16*)(ws + WS_R + R_U), (bf16*)(ws + WS_R + (rep ? R_U : 256 * MiB)), cur, (const bf16*)(ws + WS_R + R_V), (const u64*)(ws + WS_LNST), un >> 4, un & 15, nxt, gg, bb, bias0, bias1, tid);
            cur = nxt; }
        if (BOTH(7)) GRID_BAR(); }
    }
    if (IN(8)) {
        Gemm g{(const bf16*)(ws + WS_R + R_U), (const bf16*)(ws + WS_W_SOUT), M, 2048, 2048, 0}; StaticOrder S; S.init(M, 2048, G, bx);
        EpiResidB16 E{xb, xb, nullptr, nullptr, 0.f};
        REPS(8) { gemm_phase<EpiResidB16, StaticOrder, true, true>(lds, g, S, E, wave);
        if (BOTH(8)) GRID_BAR(); }
    }
    if (IN(9)) { const Args args = ldargs(); router_phase(args, lds, G, TIDX()); if (BOTH(9)) GRID_BAR(); }
    if (IN(10)) { const Args args = ldargs(); REPS(10) { assign_phase(args, (volatile LAS int*)(MISC + 16), (volatile LAS int*)(MISC + 48), vcu, G, TIDX()); if (BOTH(10)) GRID_BAR(); } }
    if (IN(11)) {
        const int np = __builtin_amdgcn_readfirstlane(((const int*)(ws + WS_NPAN))[0]);
        Gemm g{(const bf16*)(ws + WS_R + R_AS), (const bf16*)(ws + WS_W_MGU), np * 256, 2 * DFFE, 1024, (size_t)2 * DFFE * 2048};
        MoeOrder S; S.init(np, 2 * DFFE / 256, G, bx, (const int*)(ws + WS_PANE));
        EpiSwiglu8 E{ws + WS_R + R_H, DFFE, 1.0f / (F8_SA * F8_SW_UP), F8_SH};
        REPS(11) { gemm_phase<EpiSwiglu8, MoeOrder, true, true, true>(lds, g, S, E, wave);
        if (BOTH(11)) GRID_BAR(); }
    }
    if (IN(12)) {
        const int np = __builtin_amdgcn_readfirstlane(((const int*)(ws + WS_NPAN))[0]);
        Gemm g{(const bf16*)(ws + WS_R + R_H), (const bf16*)(ws + WS_W_MD), np * 256, 2048, DFFE / 2, (size_t)2048 * DFFE};
        MoeOrder S; S.init(np, 8, G, bx, (const int*)(ws + WS_PANE));
        EpiY E{(bf16*)(ws + WS_R + R_Y), (const int*)(ws + WS_ROWTOK), (const float*)(ws + WS_ROWW), 1.0f / (F8_SH * F8_SW_DN)};
        REPS(12) { gemm_phase<EpiY, MoeOrder, true, F8SP2, true>(lds, g, S, E, wave);
        if (BOTH(12) || (IN(12) && IN(15))) GRID_BAR(); }
    }
    if (IN(15)) {
        const Args args = ldargs();
        const float* fg = args.in[22]; const int gw = vcu * NWAVES + wave, NGW = G * NWAVES, lane = LANE();
        f32x4 gv[8];
#pragma unroll
        for (int j = 0; j < 4; ++j) { gv[2 * j] = ((const f32x4*)fg)[2 * lane + 128 * j]; gv[2 * j + 1] = ((const f32x4*)fg)[2 * lane + 1 + 128 * j]; }
        REPS(15) { float* dsto = rep ? out : (float*)(ws + WS_R + 272 * MiB);
        for (int m = gw; m < M; m += NGW) {
            const v4u* xr = (const v4u*)(xb + (size_t)m * D) + lane; f32x4* xw = (f32x4*)(dsto + (size_t)m * D) + 2 * lane; f32x4 v[8]; float s = 0.f;
            const v4u* y0 = (const v4u*)((const bf16*)(ws + WS_R + R_Y) + (size_t)m * D) + lane; const v4u* y1 = (const v4u*)((const bf16*)(ws + WS_R + R_Y) + (size_t)(M + m) * D) + lane;
#pragma unroll
            for (int j = 0; j < 4; ++j) { const v4u a0 = y0[64 * j], a1 = y1[64 * j], xq = xr[64 * j];
                v[2 * j] = (f32x4){bflo(xq.x) + (bflo(a0.x) + bflo(a1.x)), bfhi(xq.x) + (bfhi(a0.x) + bfhi(a1.x)), bflo(xq.y) + (bflo(a0.y) + bflo(a1.y)), bfhi(xq.y) + (bfhi(a0.y) + bfhi(a1.y))};
                v[2 * j + 1] = (f32x4){bflo(xq.z) + (bflo(a0.z) + bflo(a1.z)), bfhi(xq.z) + (bfhi(a0.z) + bfhi(a1.z)), bflo(xq.w) + (bflo(a0.w) + bflo(a1.w)), bfhi(xq.w) + (bfhi(a0.w) + bfhi(a1.w))};
                s += ((v[2 * j].x * v[2 * j].x + v[2 * j].y * v[2 * j].y) + (v[2 * j].z * v[2 * j].z + v[2 * j].w * v[2 * j].w)) + ((v[2 * j + 1].x * v[2 * j + 1].x + v[2 * j + 1].y * v[2 * j + 1].y) + (v[2 * j + 1].z * v[2 * j + 1].z + v[2 * j + 1].w * v[2 * j + 1].w)); }
            const float rs = 1.0f / sqrtf(wave_sum(s) * (1.0f / 2048.0f) + EPS);
#pragma unroll
            for (int j = 0; j < 4; ++j) { __builtin_nontemporal_store(v[2 * j] * rs * gv[2 * j], xw + 128 * j); __builtin_nontemporal_store(v[2 * j + 1] * rs * gv[2 * j + 1], xw + 128 * j + 1); }
        }
        if (rep == 0) GRID_BAR(); }
    }
#undef IN
#undef BOTH
}

extern "C" void kernel_launch(void* const* d_in, const int* in_sizes, int n_in, void* d_out, int out_size, void* d_ws, size_t ws_size, hipStream_t stream) {
    static int grid = 0;
    if (grid == 0) {
        if (n_in != 23 || in_sizes[0] != M * D || out_size != M * D || ws_size < WS_END) { fprintf(stderr, "kernel_launch: shape/workspace mismatch (n_in %d, in0 %d, out %d, ws %zu, need %zu)\n", n_in, n_in > 0 ? in_sizes[0] : -1, out_size, ws_size, (size_t)WS_END); grid = -1; return; }
        int dev = 0, cus = 0, per_cu = 0;
        if (hipGetDevice(&dev) != hipSuccess || hipDeviceGetAttribute(&cus, hipDeviceAttributeMultiprocessorCount, dev) != hipSuccess) { grid = -1; return; }
        if (hipFuncSetAttribute((const void*)trunk_fwd, hipFuncAttributeMaxDynamicSharedMemorySize, LDS_BYTES) != hipSuccess) { fprintf(stderr, "kernel_launch: hipFuncSetAttribute failed\n"); grid = -1; return; }
        if (hipOccupancyMaxActiveBlocksPerMultiprocessor(&per_cu, (const void*)trunk_fwd, NWAVES * 64, LDS_BYTES) != hipSuccess || per_cu < 1) fprintf(stderr, "kernel_launch: occupancy query reports %d\n", per_cu);
        (void)hipGetLastError();
        grid = cus;
    }
    if (grid < 0) return;
    if (hipMemsetAsync((char*)d_ws + WS_CTL, 0, CTL_ZERO_BYTES, stream) != hipSuccess) return;
    Args a{};
    for (int i = 0; i < 23; ++i) a.in[i] = (const float*)d_in[i];
    a.out = (float*)d_out; a.ws = (unsigned char*)d_ws;
#if MK_PER_PHASE
    for (int p = 0; p < NPH; ++p) { a.ph_lo = p; a.ph_hi = p + 1; hipLaunchKernelGGL(trunk_fwd, dim3(grid), dim3(NWAVES * 64), LDS_BYTES, stream, a); }
#else
    a.ph_lo = 0; a.ph_hi = NPH;
    hipLaunchKernelGGL(trunk_fwd, dim3(grid), dim3(NWAVES * 64), LDS_BYTES, stream, a);
#endif
}
```

```cpp
#include <hip/hip_runtime.h>
#include <cstdio>
#include <cstdint>

#ifndef MK_PER_PHASE
#define MK_PER_PHASE 0
#endif

#ifndef KF_DEFAULT
#define KF_DEFAULT false
#endif
#ifndef KF_SWIGLU
#define KF_SWIGLU true
#endif
#ifndef KF_SGU
#define KF_SGU true
#endif
#ifndef ASM_STAGE
#define ASM_STAGE true
#endif
namespace pg8 {
#define PG8_LAS __attribute__((address_space(3)))
typedef unsigned short bf16_t;
typedef short bf16x8 __attribute__((ext_vector_type(8)));
typedef float f32x4 __attribute__((ext_vector_type(4)));
typedef float f32x2 __attribute__((ext_vector_type(2)));
typedef unsigned u32x4 __attribute__((ext_vector_type(4)));
typedef unsigned u32x2 __attribute__((ext_vector_type(2)));
typedef int i32x4 __attribute__((ext_vector_type(4)));
typedef int i32x8 __attribute__((ext_vector_type(8)));
__device__ __forceinline__ i32x8 cat8(bf16x8 a, bf16x8 b) { const i32x4 x = __builtin_bit_cast(i32x4, a), y = __builtin_bit_cast(i32x4, b); return __builtin_shufflevector(x, y, 0, 1, 2, 3, 4, 5, 6, 7); }
template <int OFF> __device__ __forceinline__ void glds16_s(const void* sbase, unsigned voff, unsigned lds_w) {
    const unsigned long long gb = (unsigned long long)sbase;
    const unsigned lo = __builtin_amdgcn_readfirstlane((unsigned)gb), hi = __builtin_amdgcn_readfirstlane((unsigned)(gb >> 32));
    const unsigned long long sb = ((unsigned long long)hi << 32) | lo; unsigned keep;
    asm volatile("s_mov_b32 %0, m0\n\ts_add_i32 m0, %3, %4\n\ts_nop 0\n\tglobal_load_lds_dwordx4 %1, %2\n\ts_mov_b32 m0, %0" : "=&s"(keep) : "v"(voff), "s"(sb), "s"(lds_w), "i"(OFF) : "memory", "scc");
}
__device__ __forceinline__ unsigned pk4_fp8(float a, float b, float c, float d) {
    a = __builtin_amdgcn_fmed3f(a, -448.f, 448.f); b = __builtin_amdgcn_fmed3f(b, -448.f, 448.f); c = __builtin_amdgcn_fmed3f(c, -448.f, 448.f); d = __builtin_amdgcn_fmed3f(d, -448.f, 448.f);
    int w = __builtin_amdgcn_cvt_pk_fp8_f32(a, b, 0, false); w = __builtin_amdgcn_cvt_pk_fp8_f32(c, d, w, true); return (unsigned)w; }
__device__ __forceinline__ unsigned pk4_i8(float a, float b, float c, float d) {
    a = __builtin_amdgcn_fmed3f(a, -127.f, 127.f) + 12582912.0f; b = __builtin_amdgcn_fmed3f(b, -127.f, 127.f) + 12582912.0f; c = __builtin_amdgcn_fmed3f(c, -127.f, 127.f) + 12582912.0f; d = __builtin_amdgcn_fmed3f(d, -127.f, 127.f) + 12582912.0f;
    const unsigned p01 = __builtin_amdgcn_perm(__builtin_bit_cast(unsigned, b), __builtin_bit_cast(unsigned, a), 0x0c0c0400u), p23 = __builtin_amdgcn_perm(__builtin_bit_cast(unsigned, d), __builtin_bit_cast(unsigned, c), 0x0c0c0400u);
    return __builtin_amdgcn_perm(p23, p01, 0x05040100u); }
constexpr int BM = 256, BK = 64, HALF = 128, HTB = HALF * BK * 2  , STAGE_BYTES = 8 * HTB, NXCD = 8, WGM = 8;

__host__ __device__ __forceinline__ int lds_byte(int r, int c) { const int st = (r >> 4) * 2 + (c >> 5), rr = r & 15, cc = c & 31, ob = rr * 64 + cc * 2; return st * 1024 + (ob ^ (((ob >> 9) & 1) << 5)); }
__host__ __device__ __forceinline__ void stage_rc(int b, int& R, int& C) { const int st = b / 1024, sb = b % 1024, swz = sb ^ (((sb >> 9) & 1) << 5); R = (st >> 1) * 16 + swz / 64; C = (st & 1) * 32 + (swz % 64) / 2; }
__host__ __device__ __forceinline__ int perm32(int rho) { const int n = rho >> 4, i = rho & 15; return 8 * (i >> 2) + 4 * n + (i & 3); }

struct Unit { int pm, pn, e; };
struct Gemm { const bf16_t* A; const bf16_t* Bt; int M, N, K; size_t estride; };

struct StaticOrder {
    int nM, nN, nwg, G, c;
    __host__ __device__ void init(int M, int N, int G_, int c_) { nM = M / BM; nN = N / BM; nwg = nM * nN; G = G_; c = c_; }
    __host__ __device__ bool next(int i, Unit& u) const {
        const long L = (long)i * G + c; if (L >= nwg) return false;
        int wgid = (int)L; { const int q = nwg / NXCD, r = nwg % NXCD, xcd = wgid % NXCD, off = wgid / NXCD; wgid = (xcd < r ? xcd * (q + 1) : r * (q + 1) + (xcd - r) * q) + off; }
        const int nig = WGM * nN, gid = wgid / nig, fm = gid * WGM, gsz = (nM - fm) < WGM ? (nM - fm) : WGM;
        u.pm = fm + ((wgid % nig) % gsz); u.pn = (wgid % nig) / gsz; u.e = 0; return true;
    }
    __device__ __forceinline__ void a_ready(const Unit&) const {}
    __device__ __forceinline__ void done(const Unit&) const {}
};
struct ConstOrder {
    int nwg, G, c;
    __device__ void init(int M, int N, int G_, int c_) { nwg = (M / BM) * (N / BM); G = G_; c = c_; }
    __device__ bool next(int i, Unit& u) const { const long L = (long)i * G + c; if (L >= nwg) return false; u.pm = 0; u.pn = 0; u.e = 0; return true; }
    __device__ __forceinline__ void a_ready(const Unit&) const {}
    __device__ __forceinline__ void done(const Unit&) const {}
};
struct MoeOrder {
    int nM, nN, nwg, G, c; const int* panel_e;
    __device__ void init(int nM_, int nN_, int G_, int c_, const int* pe) { nM = nM_; nN = nN_; nwg = nM * nN; G = G_; c = c_; panel_e = pe; }
    __device__ bool next(int i, Unit& u) const {
        const long L = (long)i * G + c; if (L >= nwg) return false;
        int wgid = (int)L; { const int q = nwg / NXCD, r = nwg % NXCD, xcd = wgid % NXCD, off = wgid / NXCD; wgid = (xcd < r ? xcd * (q + 1) : r * (q + 1) + (xcd - r) * q) + off; }
        const int nig = WGM * nN, gid = wgid / nig, fm = gid * WGM, gsz = (nM - fm) < WGM ? (nM - fm) : WGM;
        u.pm = fm + ((wgid % nig) % gsz); u.pn = (wgid % nig) / gsz; u.e = __builtin_amdgcn_readfirstlane(panel_e[u.pm]); return true;
    }
    __device__ __forceinline__ void a_ready(const Unit&) const {}
    __device__ __forceinline__ void done(const Unit&) const {}
};

__device__ __forceinline__ unsigned cvt_pk_bf16(float lo, float hi) { unsigned r; asm volatile("v_cvt_pk_bf16_f32 %0, %1, %2" : "=v"(r) : "v"(lo), "v"(hi)); return r; }
__device__ __forceinline__ f32x2 gelu_pk(f32x2 v) {
    const f32x2 av = __builtin_elementwise_abs(v), d = av * 0.2316418882f + 1.0f;
    f32x2 t; t.x = __builtin_amdgcn_rcpf(d.x); t.y = __builtin_amdgcn_rcpf(d.y);
    f32x2 q = t * 0.5307027145f + (-0.7265760135f); q = q * t + 0.7107068705f; q = q * t + (-0.142248368f); q = q * t + 0.127414796f; q = q * t;
    const f32x2 s = (v * v) * (-0.72134752044f);
    f32x2 e; e.x = __builtin_amdgcn_exp2f(s.x); e.y = __builtin_amdgcn_exp2f(s.y);
    const f32x2 m = av * (q * e);
    f32x2 o; o.x = fmaxf(v.x, 0.f) - m.x; o.y = fmaxf(v.y, 0.f) - m.y; return o;
}
__device__ __forceinline__ float fsilu(float x) { return x * __builtin_amdgcn_rcpf(1.f + __builtin_amdgcn_exp2f(-1.44269504f * x)); }
constexpr float INV_D = 1.0f / 2048.0f, RMS_EPS = 1e-6f;
constexpr float FX_SCALE = 16777216.0f, FX_INV = 1.0f / 16777216.0f;
typedef unsigned long long u64;
__device__ __forceinline__ void fx_add(u64* p, float v) { atomicAdd(p, (u64)(long long)__float2ll_rn(v * FX_SCALE)); }
__device__ __forceinline__ float fx_get(const u64* p) { return (float)(long long)(*p) * FX_INV; }
constexpr int RSL_OFF = 131072;
__device__ __forceinline__ void rs_prefetch(const u64* rss, int pm, PG8_LAS unsigned char* lds, int wid, int slot) {
    const int lane = (int)__builtin_amdgcn_mbcnt_hi(~0u, __builtin_amdgcn_mbcnt_lo(~0u, 0u));
    const unsigned dst = __builtin_amdgcn_readfirstlane((unsigned)(size_t)lds + (unsigned)(RSL_OFF + slot * 2048 + (wid & 1) * 1024));
    glds16_s<0>((const void*)(rss + (size_t)pm * 256), (unsigned)((wid & 1) * 1024 + lane * 16), dst);
}
__device__ __forceinline__ float fx_get_lds(const PG8_LAS u64* p) { return (float)(long long)(*p) * FX_INV; }
__device__ __forceinline__ float fx_rs_lds(const PG8_LAS u64* p, float sc) { const u64 v = *p;
    const float m = __builtin_fmaf((float)(unsigned)(v >> 32), 4294967296.0f * FX_INV * INV_D, __builtin_fmaf((float)(unsigned)v, FX_INV * INV_D, RMS_EPS)); return sc * __builtin_amdgcn_rsqf(m); }

struct EpiHgrnIn {
    static constexpr bool PERM = true, AFTER_DRAIN = false, RSP = false, KEEPF = KF_DEFAULT;
    float sc; const float* lb; bf16_t *Q, *Gl, *Iv, *Gt;
    __device__ __forceinline__ void operator()(const f32x4 (&acc)[2][2][4][2], const Unit& u, int wr, int wc, int fr, int fq) const {
        const int seg = u.pn >> 3, row0 = u.pm * BM + wr * 64 + fr, col0 = (u.pn & 7) * BM + wc * 32 + 8 * fq;
        const float k1 = -1.44269504f * sc, isc = 1.0f / sc, fcl = 30.f / sc;
        auto isilu = [k1, isc](float t) { return t * __builtin_amdgcn_rcpf(__builtin_fmaf(__builtin_amdgcn_exp2f(t * k1), isc, isc)); };
        float lv[2][8];
        if (seg == 1) {
#pragma unroll
            for (int bj = 0; bj < 2; ++bj) { const f32x4 l0 = *(const f32x4*)(lb + col0 + bj * HALF), l1 = *(const f32x4*)(lb + col0 + bj * HALF + 4);
                lv[bj][0] = l0[0]; lv[bj][1] = l0[1]; lv[bj][2] = l0[2]; lv[bj][3] = l0[3]; lv[bj][4] = l1[0]; lv[bj][5] = l1[1]; lv[bj][6] = l1[2]; lv[bj][7] = l1[3];
#pragma unroll
                for (int j = 0; j < 8; ++j) asm volatile("" : "+v"(lv[bj][j])); } }
#pragma unroll
        for (int ai = 0; ai < 2; ++ai)
#pragma unroll
            for (int m = 0; m < 4; ++m) {
                const int r = row0 + ai * HALF + m * 16; const size_t off = (size_t)r * 2048 + col0;
#pragma unroll
                for (int bj = 0; bj < 2; ++bj) {
                    const i32x4 i0 = __builtin_bit_cast(i32x4, acc[ai][bj][m][0]), i1 = __builtin_bit_cast(i32x4, acc[ai][bj][m][1]);
                    const float v[8] = {(float)i0[0], (float)i0[1], (float)i0[2], (float)i0[3], (float)i1[0], (float)i1[1], (float)i1[2], (float)i1[3]};
                    if (seg == 0) { u32x4 w; w.x = cvt_pk_bf16(isilu(v[0]), isilu(v[1])); w.y = cvt_pk_bf16(isilu(v[2]), isilu(v[3])); w.z = cvt_pk_bf16(isilu(v[4]), isilu(v[5])); w.w = cvt_pk_bf16(isilu(v[6]), isilu(v[7])); *(u32x4*)(Q + off + bj * HALF) = w; }
                    else if (seg == 1) {
                        float gl[8];
#pragma unroll
                        for (int j = 0; j < 8; ++j) { const float f = __builtin_amdgcn_fmed3f(v[j], -fcl, fcl), e = __builtin_amdgcn_exp2f(k1 * f), sg = __builtin_amdgcn_rcpf(1.f + e), om = 1.f - lv[bj][j];
                            gl[j] = __logf(lv[bj][j] + om * sg); }
                        u32x4 w; w.x = cvt_pk_bf16(gl[0], gl[1]); w.y = cvt_pk_bf16(gl[2], gl[3]); w.z = cvt_pk_bf16(gl[4], gl[5]); w.w = cvt_pk_bf16(gl[6], gl[7]); *(u32x4*)(Gl + off + bj * HALF) = w; }
                    else if (seg == 2) { u32x4 w; w.x = cvt_pk_bf16(v[0] * sc, v[1] * sc); w.y = cvt_pk_bf16(v[2] * sc, v[3] * sc); w.z = cvt_pk_bf16(v[4] * sc, v[5] * sc); w.w = cvt_pk_bf16(v[6] * sc, v[7] * sc); *(u32x4*)(Iv + off + bj * HALF) = w; }
                    else { u32x4 w; w.x = cvt_pk_bf16(isilu(v[0]), isilu(v[1])); w.y = cvt_pk_bf16(isilu(v[2]), isilu(v[3])); w.z = cvt_pk_bf16(isilu(v[4]), isilu(v[5])); w.w = cvt_pk_bf16(isilu(v[6]), isilu(v[7])); *(u32x4*)(Gt + off + bj * HALF) = w; }
                } }
    }
};

template <bool RB16, bool WF32> struct EpiResid {
    static constexpr bool PERM = false, AFTER_DRAIN = false, RSP = false, KEEPF = KF_DEFAULT;
    const float* resid; const bf16_t* rb16; float* out; bf16_t* xb; u64* rowss; unsigned char* x8; float sc8;
    __device__ __forceinline__ void operator()(const f32x4 (&acc)[2][2][4][2], const Unit& u, int wr, int wc, int fr, int fq) const {
        const int row0 = u.pm * BM + wr * 64 + fr, col0 = u.pn * BM + wc * 32 + 4 * fq;
#pragma unroll
        for (int ai = 0; ai < 2; ++ai) {
            f32x4 rv[4][4];
#pragma unroll
            for (int m = 0; m < 4; ++m) { const size_t off = (size_t)(row0 + ai * HALF + m * 16) * 2048 + col0;
#pragma unroll
                for (int q = 0; q < 4; ++q) { const int c = (q >> 1) * HALF + (q & 1) * 16;
                    if (RB16) { const u32x2 b = *(const u32x2*)(rb16 + off + c); rv[m][q] = (f32x4){__builtin_bit_cast(float, b.x << 16), __builtin_bit_cast(float, b.x & 0xffff0000u), __builtin_bit_cast(float, b.y << 16), __builtin_bit_cast(float, b.y & 0xffff0000u)}; }
                    else rv[m][q] = *(const f32x4*)(resid + off + c); } }
#pragma unroll
            for (int m = 0; m < 4; ++m) { const int r = row0 + ai * HALF + m * 16; const size_t off = (size_t)r * 2048 + col0; float ss = 0.f;
#pragma unroll
                for (int q = 0; q < 4; ++q) { const int c = (q >> 1) * HALF + (q & 1) * 16;
                    const f32x4 v = rv[m][q] + acc[ai][q >> 1][m][q & 1]; if (WF32) *(f32x4*)(out + off + c) = v; ss += (v[0] * v[0] + v[1] * v[1]) + (v[2] * v[2] + v[3] * v[3]);
                    if (xb) { u32x2 p; p.x = cvt_pk_bf16(v[0], v[1]); p.y = cvt_pk_bf16(v[2], v[3]); *(u32x2*)(xb + off + c) = p; }
                    if (x8) *(unsigned*)(x8 + off + c) = pk4_i8(v[0] * sc8, v[1] * sc8, v[2] * sc8, v[3] * sc8); }
                if (rowss) { ss += __shfl_xor(ss, 16); ss += __shfl_xor(ss, 32); if (fq == 0) fx_add(rowss + r, ss); } }
            asm volatile("" ::: "memory"); }
    }
};

struct EpiResidB16 {
    static constexpr bool PERM = true, AFTER_DRAIN = false, RSP = false, KEEPF = KF_DEFAULT;
    const bf16_t* rb16; bf16_t* xb; u64* rowss; unsigned char* x8; float sc8;
    __device__ __forceinline__ void operator()(const f32x4 (&acc)[2][2][4][2], const Unit& u, int wr, int wc, int fr, int fq) const {
        const int row0 = u.pm * BM + wr * 64 + fr, col0 = u.pn * BM + wc * 32 + 8 * fq;
#pragma unroll
        for (int ai = 0; ai < 2; ++ai) {
            u32x4 rv[4][2];
#pragma unroll
            for (int m = 0; m < 4; ++m) { const size_t off = (size_t)(row0 + ai * HALF + m * 16) * 2048 + col0;
#pragma unroll
                for (int bj = 0; bj < 2; ++bj) rv[m][bj] = *(const u32x4*)(rb16 + off + bj * HALF); }
#pragma unroll
            for (int m = 0; m < 4; ++m) { const int r = row0 + ai * HALF + m * 16; const size_t off = (size_t)r * 2048 + col0; float ss = 0.f;
#pragma unroll
                for (int bj = 0; bj < 2; ++bj) { const u32x4 b = rv[m][bj]; const f32x4 a0 = acc[ai][bj][m][0], a1 = acc[ai][bj][m][1];
                    const float v0 = __builtin_bit_cast(float, b.x << 16) + a0[0], v1 = __builtin_bit_cast(float, b.x & 0xffff0000u) + a0[1], v2 = __builtin_bit_cast(float, b.y << 16) + a0[2], v3 = __builtin_bit_cast(float, b.y & 0xffff0000u) + a0[3];
                    const float v4 = __builtin_bit_cast(float, b.z << 16) + a1[0], v5 = __builtin_bit_cast(float, b.z & 0xffff0000u) + a1[1], v6 = __builtin_bit_cast(float, b.w << 16) + a1[2], v7 = __builtin_bit_cast(float, b.w & 0xffff0000u) + a1[3];
                    ss += ((v0 * v0 + v1 * v1) + (v2 * v2 + v3 * v3)) + ((v4 * v4 + v5 * v5) + (v6 * v6 + v7 * v7));
                    u32x4 p; p.x = cvt_pk_bf16(v0, v1); p.y = cvt_pk_bf16(v2, v3); p.z = cvt_pk_bf16(v4, v5); p.w = cvt_pk_bf16(v6, v7);
                    *(u32x4*)(xb + off + bj * HALF) = p;
                    if (x8) { u32x2 q; q.x = pk4_i8(v0 * sc8, v1 * sc8, v2 * sc8, v3 * sc8); q.y = pk4_i8(v4 * sc8, v5 * sc8, v6 * sc8, v7 * sc8); *(u32x2*)(x8 + off + bj * HALF) = q; } }
                if (rowss) { ss += __shfl_xor(ss, 16); ss += __shfl_xor(ss, 32); if (fq == 0) fx_add(rowss + r, ss); } }
            asm volatile("" ::: "memory"); }
    }
};

template <bool RSD> struct EpiSwiglu {
    static constexpr bool PERM = true, AFTER_DRAIN = false, RSP = false, KEEPF = KF_DEFAULT;
    const void* rsv; bf16_t* H; int ldh;
    __device__ __forceinline__ void operator()(const f32x4 (&acc)[2][2][4][2], const Unit& u, int wr, int wc, int fr, int fq) const {
        const int row0 = u.pm * BM + wr * 64 + fr, col0 = u.pn * HALF + wc * 32 + 8 * fq;
        float rsa[8];
#pragma unroll
        for (int i = 0; i < 8; ++i) { const int r = row0 + (i >> 2) * HALF + (i & 3) * 16; rsa[i] = RSD ? ((const float*)rsv)[r] : fx_get((const u64*)rsv + r); }
        if (!RSD) {
#pragma unroll
            for (int i = 0; i < 8; ++i) rsa[i] = 1.0f / sqrtf(rsa[i] * INV_D + RMS_EPS); }
#pragma unroll
        for (int ai = 0; ai < 2; ++ai)
#pragma unroll
            for (int m = 0; m < 4; ++m) {
                const int r = row0 + ai * HALF + m * 16; const float rs = rsa[ai * 4 + m];
                const f32x4 g0 = acc[ai][0][m][0] * rs, g1 = acc[ai][0][m][1] * rs, u0 = acc[ai][1][m][0] * rs, u1 = acc[ai][1][m][1] * rs;
                u32x4 w; w.x = cvt_pk_bf16(fsilu(g0[0]) * u0[0], fsilu(g0[1]) * u0[1]); w.y = cvt_pk_bf16(fsilu(g0[2]) * u0[2], fsilu(g0[3]) * u0[3]);
                w.z = cvt_pk_bf16(fsilu(g1[0]) * u1[0], fsilu(g1[1]) * u1[1]); w.w = cvt_pk_bf16(fsilu(g1[2]) * u1[2], fsilu(g1[3]) * u1[3]);
                *(u32x4*)(H + (size_t)r * ldh + col0) = w; }
    }
};

struct EpiSwiglu8 {
    static constexpr bool PERM = true, AFTER_DRAIN = false, RSP = false, KEEPF = false;
    unsigned char* H; int ldh; float sc_in, sc_out;
    __device__ __forceinline__ void operator()(const f32x4 (&acc)[2][2][4][2], const Unit& u, int wr, int wc, int fr, int fq) const {
        const int row0 = u.pm * BM + wr * 64 + fr, col0 = u.pn * HALF + wc * 32 + 8 * fq;
        const float k1 = -1.44269504f * sc_in, k2i = __builtin_amdgcn_rcpf(sc_in * sc_in * sc_out);
#pragma unroll
        for (int ai = 0; ai < 2; ++ai)
#pragma unroll
            for (int m = 0; m < 4; ++m) {
                const int r = row0 + ai * HALF + m * 16;
                const f32x4 g0 = acc[ai][0][m][0], g1 = acc[ai][0][m][1], u0 = acc[ai][1][m][0], u1 = acc[ai][1][m][1];
                float h[8];
#pragma unroll
                for (int j = 0; j < 4; ++j) { h[j] = (g0[j] * u0[j]) * __builtin_amdgcn_rcpf(__builtin_fmaf(__builtin_amdgcn_exp2f(g0[j] * k1), k2i, k2i)); h[4 + j] = (g1[j] * u1[j]) * __builtin_amdgcn_rcpf(__builtin_fmaf(__builtin_amdgcn_exp2f(g1[j] * k1), k2i, k2i)); }
                u32x2 w; w.x = pk4_fp8(h[0], h[1], h[2], h[3]); w.y = pk4_fp8(h[4], h[5], h[6], h[7]);
                *(u32x2*)(H + (size_t)r * ldh + col0) = w; }
    }
};

template <bool ROWRS, bool OUT8> struct EpiSwigluI {
    static constexpr bool PERM = true, AFTER_DRAIN = false, RSP = ROWRS, KEEPF = KF_SWIGLU;
    void* H; int ldh; float sc_in, sc_out; const u64* rss;
    __device__ __forceinline__ void prefetch(const Unit& u, PG8_LAS unsigned char* lds, int wid, int slot) const { rs_prefetch(rss, u.pm, lds, wid, slot); }
    __device__ __forceinline__ void operator()(const f32x4 (&acc)[2][2][4][2], const Unit& u, int wr, int wc, int fr, int fq, const PG8_LAS unsigned char* rsl = nullptr) const {
        const int row0 = u.pm * BM + wr * 64 + fr, col0 = u.pn * HALF + wc * 32 + 8 * fq;
        float rsa[8];
        if (ROWRS) {
#pragma unroll
            for (int i = 0; i < 8; ++i) rsa[i] = fx_rs_lds((const PG8_LAS u64*)rsl + wr * 64 + fr + (i >> 2) * HALF + (i & 3) * 16, sc_in); }
#pragma unroll
        for (int ai = 0; ai < 2; ++ai)
#pragma unroll
            for (int m = 0; m < 4; ++m) {
                const int r = row0 + ai * HALF + m * 16; const float s = ROWRS ? rsa[ai * 4 + m] : sc_in, k1 = -1.44269504f * s, k2i = __builtin_amdgcn_rcpf(OUT8 ? s * s * sc_out : s * s);
                const i32x4 gi0 = __builtin_bit_cast(i32x4, acc[ai][0][m][0]), gi1 = __builtin_bit_cast(i32x4, acc[ai][0][m][1]), ui0 = __builtin_bit_cast(i32x4, acc[ai][1][m][0]), ui1 = __builtin_bit_cast(i32x4, acc[ai][1][m][1]);
                float h[8];
#pragma unroll
                for (int j = 0; j < 4; ++j) { const float g0 = (float)gi0[j], g1 = (float)gi1[j];
                    h[j] = (g0 * (float)ui0[j]) * __builtin_amdgcn_rcpf(__builtin_fmaf(__builtin_amdgcn_exp2f(g0 * k1), k2i, k2i)); h[4 + j] = (g1 * (float)ui1[j]) * __builtin_amdgcn_rcpf(__builtin_fmaf(__builtin_amdgcn_exp2f(g1 * k1), k2i, k2i)); }
                if (OUT8) { u32x2 w; w.x = pk4_fp8(h[0], h[1], h[2], h[3]); w.y = pk4_fp8(h[4], h[5], h[6], h[7]); *(u32x2*)((unsigned char*)H + (size_t)r * ldh + col0) = w; }
                else { u32x4 w; w.x = cvt_pk_bf16(h[0], h[1]); w.y = cvt_pk_bf16(h[2], h[3]); w.z = cvt_pk_bf16(h[4], h[5]); w.w = cvt_pk_bf16(h[6], h[7]); *(u32x4*)((bf16_t*)H + (size_t)r * ldh + col0) = w; } }
    }
};

struct EpiBf16Plain {
    static constexpr bool PERM = true, AFTER_DRAIN = false, RSP = false, KEEPF = KF_DEFAULT;
    bf16_t* O;
    __device__ __forceinline__ void operator()(const f32x4 (&acc)[2][2][4][2], const Unit& u, int wr, int wc, int fr, int fq) const {
        const int row0 = u.pm * BM + wr * 64 + fr, col0 = u.pn * BM + wc * 32 + 8 * fq;
#pragma unroll
        for (int ai = 0; ai < 2; ++ai)
#pragma unroll
            for (int m = 0; m < 4; ++m) { bf16_t* rowp = O + (size_t)(row0 + ai * HALF + m * 16) * 2048 + col0;
#pragma unroll
                for (int bj = 0; bj < 2; ++bj) { const f32x4 v0 = acc[ai][bj][m][0], v1 = acc[ai][bj][m][1];
                    u32x4 p; p.x = cvt_pk_bf16(v0[0], v0[1]); p.y = cvt_pk_bf16(v0[2], v0[3]); p.z = cvt_pk_bf16(v1[0], v1[1]); p.w = cvt_pk_bf16(v1[2], v1[3]);
                    *(u32x4*)(rowp + bj * HALF) = p; } }
    }
};

struct EpiY {
    static constexpr bool PERM = true, AFTER_DRAIN = false, RSP = false, KEEPF = KF_DEFAULT;
    bf16_t* Y; const int* row_tok; const float* row_w; float sc;
    __device__ __forceinline__ void operator()(const f32x4 (&acc)[2][2][4][2], const Unit& u, int wr, int wc, int fr, int fq) const {
        const int row0 = u.pm * BM + wr * 64 + fr, col0 = u.pn * BM + wc * 32 + 8 * fq;
        int orow[8]; float wv[8];
#pragma unroll
        for (int i = 0; i < 8; ++i) { const int r = row0 + (i >> 2) * HALF + (i & 3) * 16; orow[i] = row_tok[r]; wv[i] = row_w[r]; }
#pragma unroll
        for (int i = 0; i < 8; ++i) asm volatile("" : "+v"(orow[i]), "+v"(wv[i]));
#pragma unroll
        for (int ai = 0; ai < 2; ++ai)
#pragma unroll
            for (int m = 0; m < 4; ++m) { const int o = orow[ai * 4 + m]; const float w = wv[ai * 4 + m] * sc;
                if (o >= 0) {
#pragma unroll
                    for (int bj = 0; bj < 2; ++bj) { const f32x4 v0 = acc[ai][bj][m][0] * w, v1 = acc[ai][bj][m][1] * w;
                        u32x4 p; p.x = cvt_pk_bf16(v0[0], v0[1]); p.y = cvt_pk_bf16(v0[2], v0[3]); p.z = cvt_pk_bf16(v1[0], v1[1]); p.w = cvt_pk_bf16(v1[2], v1[3]);
                        *(u32x4*)(Y + (size_t)o * 2048 + col0 + bj * HALF) = p; } } }
    }
};

struct EpiNull {
    static constexpr bool PERM = true, AFTER_DRAIN = false, RSP = false, KEEPF = KF_DEFAULT;
    bf16_t* H; int ldh;
    __device__ __forceinline__ void operator()(const f32x4 (&acc)[2][2][4][2], const Unit& u, int wr, int wc, int fr, int fq) const {
        const int row0 = u.pm * BM + wr * 64 + fr, col0 = u.pn * HALF + wc * 32 + 8 * fq;
#pragma unroll
        for (int ai = 0; ai < 2; ++ai)
#pragma unroll
            for (int m = 0; m < 4; ++m) { const int r = row0 + ai * HALF + m * 16;
                const f32x4 s = (acc[ai][0][m][0] + acc[ai][0][m][1]) + (acc[ai][1][m][0] + acc[ai][1][m][1]);
                u32x4 w; w.x = __builtin_bit_cast(unsigned, s[0]); w.y = __builtin_bit_cast(unsigned, s[1]); w.z = __builtin_bit_cast(unsigned, s[2]); w.w = __builtin_bit_cast(unsigned, s[3]);
                *(u32x4*)(H + (size_t)r * ldh + col0) = w; }
    }
};

struct EpiSguIn {
    static constexpr bool PERM = true, AFTER_DRAIN = false, RSP = true, KEEPF = KF_SGU;
    const u64* rowss; bf16_t *U, *V; u64* stats; float sc_in;
    __device__ __forceinline__ void prefetch(const Unit& u, PG8_LAS unsigned char* lds, int wid, int slot) const { rs_prefetch(rowss, u.pm, lds, wid, slot); }
    __device__ __forceinline__ void operator()(const f32x4 (&acc)[2][2][4][2], const Unit& u, int wr, int wc, int fr, int fq, const PG8_LAS unsigned char* rsl) const {
        const bool isv = u.pn >= 8; const int row0 = u.pm * BM + wr * 64 + fr, col0 = (u.pn & 7) * BM + wc * 32 + 8 * fq; bf16_t* base = isv ? V : U;
        float rsa[8];
#pragma unroll
        for (int i = 0; i < 8; ++i) rsa[i] = fx_rs_lds((const PG8_LAS u64*)rsl + wr * 64 + fr + (i >> 2) * HALF + (i & 3) * 16, sc_in);
#pragma unroll
        for (int ai = 0; ai < 2; ++ai)
#pragma unroll
            for (int m = 0; m < 4; ++m) {
                const int r = row0 + ai * HALF + m * 16; const float rs = rsa[ai * 4 + m]; float s1 = 0.f, s2 = 0.f;
#pragma unroll
                for (int bj = 0; bj < 2; ++bj) {
                    const i32x4 i0 = __builtin_bit_cast(i32x4, acc[ai][bj][m][0]), i1 = __builtin_bit_cast(i32x4, acc[ai][bj][m][1]);
                    const f32x4 v0 = (f32x4){(float)i0[0], (float)i0[1], (float)i0[2], (float)i0[3]} * rs, v1 = (f32x4){(float)i1[0], (float)i1[1], (float)i1[2], (float)i1[3]} * rs;
                    const f32x2 a = gelu_pk((f32x2){v0[0], v0[1]}), b = gelu_pk((f32x2){v0[2], v0[3]}), c = gelu_pk((f32x2){v1[0], v1[1]}), d = gelu_pk((f32x2){v1[2], v1[3]});
                    s1 += (a.x + a.y) + (b.x + b.y) + (c.x + c.y) + (d.x + d.y); s2 += (a.x * a.x + a.y * a.y) + (b.x * b.x + b.y * b.y) + (c.x * c.x + c.y * c.y) + (d.x * d.x + d.y * d.y);
                    u32x4 w; w.x = cvt_pk_bf16(a.x, a.y); w.y = cvt_pk_bf16(b.x, b.y); w.z = cvt_pk_bf16(c.x, c.y); w.w = cvt_pk_bf16(d.x, d.y);
                    *(u32x4*)(base + (size_t)r * 2048 + col0 + bj * HALF) = w; }
                if (isv) { s1 += __shfl_xor(s1, 16); s1 += __shfl_xor(s1, 32); s2 += __shfl_xor(s2, 16); s2 += __shfl_xor(s2, 32);
                    if (fq == 0) { fx_add(stats + 2 * r, s1); fx_add(stats + 2 * r + 1, s2); } } }
    }
};

template <class Epi, class Sched, bool ALIGN_EPI = false, bool SP2 = false, bool F8 = false, bool I8 = false>
__device__ __forceinline__ void gemm_phase(PG8_LAS unsigned char* lds, const Gemm g, const Sched& S, const Epi& E, const int wv  ) {
    int tid_ = wv * 64 + (int)__builtin_amdgcn_mbcnt_hi(~0u, __builtin_amdgcn_mbcnt_lo(~0u, 0u)); asm volatile("" : "+v"(tid_));
    const int tid = tid_, wid = __builtin_amdgcn_readfirstlane(tid >> 6), lane = tid & 63, wr = wid >> 2, wc = wid & 3, fr = lane & 15, fq = lane >> 4;
    const int K = g.K, nt = K / BK;
    unsigned voffA[2], voffB[2];
#pragma unroll
    for (int i = 0; i < 2; ++i) { int R, C; stage_rc(tid * 16 + i * 8192, R, C); const int Rb = Epi::PERM ? ((R & ~31) + perm32(R & 31)) : R;
        voffA[i] = (unsigned)(R * K + C) * 2u; voffB[i] = (unsigned)(Rb * K + C) * 2u; }
    const size_t kstep = (size_t)(BK * 2);
    const size_t hstep = (size_t)HALF * K * 2;
    const size_t tstep = 2 * hstep;
    const unsigned ldsw = (unsigned)wid * 1024u;
    const unsigned lds_w = __builtin_amdgcn_readfirstlane((unsigned)(size_t)lds + ldsw);
    const int aoff = lds_byte(wr * 64 + fr, fq * 8), boff = lds_byte(wc * 32 + fr, fq * 8);
#define PG8_SA(b, h) (((b) * 2 + (h)) * HTB)
#define PG8_SB(b, h) ((4 + (b) * 2 + (h)) * HTB)
#define PG8_STAGE(bufoff, gbase, voff) do { \
        if constexpr (F8 || ASM_STAGE) { glds16_s<(bufoff)>((const void*)(gbase), (voff)[0], lds_w); glds16_s<(bufoff) + 8192>((const void*)(gbase), (voff)[1], lds_w); } \
        else { _Pragma("unroll") for (int _i = 0; _i < 2; ++_i) __builtin_amdgcn_global_load_lds((const unsigned*)((const char*)(gbase) + (voff)[_i]), (PG8_LAS unsigned*)(lds + (bufoff) + ldsw + _i * 8192), 16, 0, 0); } } while (0)
#define PG8_LDA(dst, b, h) do { _Pragma("unroll") for (int m = 0; m < 4; ++m) _Pragma("unroll") for (int k = 0; k < 2; ++k) dst[m][k] = *(const PG8_LAS bf16x8*)(lds + PG8_SA(b, h) + aoff + m * 2048 + k * 1024); } while (0)
#define PG8_LDB(dst, b, h) do { _Pragma("unroll") for (int n = 0; n < 2; ++n) _Pragma("unroll") for (int k = 0; k < 2; ++k) dst[n][k] = *(const PG8_LAS bf16x8*)(lds + PG8_SB(b, h) + boff + n * 2048 + k * 1024); } while (0)
#define PG8_MMA(ai, bj, At, Bt) PG8_MMAX(ai, bj, At, Bt, false)
#define PG8_MMAX(ai, bj, At, Bt, Z) do { __builtin_amdgcn_s_setprio(1); const f32x4 z4_ = (f32x4){0.f, 0.f, 0.f, 0.f}; (void)z4_; \
        if constexpr (F8) { _Pragma("unroll") for (int m = 0; m < 4; ++m) _Pragma("unroll") for (int n = 0; n < 2; ++n) \
            acc[ai][bj][m][n] = __builtin_amdgcn_mfma_scale_f32_16x16x128_f8f6f4(cat8(Bt[n][0], Bt[n][1]), cat8(At[m][0], At[m][1]), (Z) ? z4_ : acc[ai][bj][m][n], 0, 0, 0, 0, 0, 0); } \
        else if constexpr (I8) { _Pragma("unroll") for (int m = 0; m < 4; ++m) _Pragma("unroll") for (int n = 0; n < 2; ++n) _Pragma("unroll") for (int k = 0; k < 2; ++k) \
            acc[ai][bj][m][n] = __builtin_bit_cast(f32x4, __builtin_amdgcn_mfma_i32_16x16x64_i8(__builtin_bit_cast(i32x4, Bt[n][k]), __builtin_bit_cast(i32x4, At[m][k]), __builtin_bit_cast(i32x4, ((Z) && k == 0) ? z4_ : acc[ai][bj][m][n]), 0, 0, 0)); } \
        else { _Pragma("unroll") for (int m = 0; m < 4; ++m) _Pragma("unroll") for (int n = 0; n < 2; ++n) _Pragma("unroll") for (int k = 0; k < 2; ++k) \
            acc[ai][bj][m][n] = __builtin_amdgcn_mfma_f32_16x16x32_bf16(Bt[n][k], At[m][k], ((Z) && k == 0) ? z4_ : acc[ai][bj][m][n], 0, 0, 0); } \
        __builtin_amdgcn_s_setprio(0); } while (0)
#define PG8_WAIT_V(n) asm volatile("s_waitcnt vmcnt(" #n ")" ::: "memory")
#define PG8_WAIT_L(n) asm volatile("s_waitcnt lgkmcnt(" #n ")" ::: "memory")
#define PG8_BAR __builtin_amdgcn_s_barrier()
#define PG8_SCHED __builtin_amdgcn_sched_barrier(0)
    Unit cur, nxt; int ui = 0;
    if (!S.next(0, cur)) return;
    f32x4 acc[2][2][4][2];
#pragma unroll
    for (int a = 0; a < 2; ++a)
#pragma unroll
        for (int b = 0; b < 2; ++b)
#pragma unroll
            for (int m = 0; m < 4; ++m)
#pragma unroll
                for (int n = 0; n < 2; ++n) { if constexpr (!SP2) acc[a][b][m][n] = (f32x4){0.f, 0.f, 0.f, 0.f}; }
    bf16x8 At[4][2], B0[2][2], B1[2][2];
    const char* cA = (const char*)g.A + (size_t)cur.pm * tstep; const char* cB = (const char*)g.Bt + (size_t)cur.e * g.estride + (size_t)cur.pn * tstep;
    S.a_ready(cur);
    if constexpr (Epi::RSP) E.prefetch(cur, lds, wid, 0);
    if constexpr (SP2) {
        PG8_STAGE(PG8_SB(0, 0), cB, voffB); PG8_STAGE(PG8_SB(0, 1), cB + hstep, voffB); PG8_STAGE(PG8_SA(0, 0), cA, voffA); PG8_STAGE(PG8_SA(0, 1), cA + hstep, voffA);
        if (wr == 1) PG8_BAR;
        PG8_WAIT_V(2); PG8_BAR;
        PG8_STAGE(PG8_SB(1, 0), cB + kstep, voffB); PG8_STAGE(PG8_SA(1, 0), cA + kstep, voffA); PG8_STAGE(PG8_SB(1, 1), cB + hstep + kstep, voffB);
        PG8_WAIT_V(6); PG8_BAR;
    } else {
        PG8_STAGE(PG8_SB(0, 0), cB, voffB); PG8_STAGE(PG8_SA(0, 0), cA, voffA); PG8_STAGE(PG8_SB(0, 1), cB + hstep, voffB); PG8_STAGE(PG8_SA(0, 1), cA + hstep, voffA);
        if (wr == 1) PG8_BAR;
        PG8_WAIT_V(4); PG8_BAR;
        PG8_STAGE(PG8_SB(1, 0), cB + kstep, voffB); PG8_STAGE(PG8_SA(1, 0), cA + kstep, voffA); PG8_STAGE(PG8_SB(1, 1), cB + hstep + kstep, voffB);
        PG8_WAIT_V(6); PG8_BAR;
    }
    for (;;) {
        const bool has_next = S.next(ui + 1, nxt);
        const char* nA = has_next ? (const char*)g.A + (size_t)nxt.pm * tstep : cA; const char* nB = has_next ? (const char*)g.Bt + (size_t)nxt.e * g.estride + (size_t)nxt.pn * tstep : cB;
        for (int t = 0; t < nt; t += 2) {
            const bool last = (t == nt - 2);
            const char* a1 = cA + (size_t)(t + 1) * kstep;
            const char* a2 = last ? nA : cA + (size_t)(t + 2) * kstep; const char* b2 = last ? nB : cB + (size_t)(t + 2) * kstep;
            const char* a3 = a2 + kstep; const char* b3 = b2 + kstep;
            if (last && has_next) { S.a_ready(nxt); if constexpr (Epi::RSP) E.prefetch(nxt, lds, wid, (ui + 1) & 1); }
            if constexpr (SP2) {
            PG8_LDB(B0, 0, 0); PG8_LDB(B1, 0, 1); PG8_SCHED; PG8_LDA(At, 0, 0); PG8_STAGE(PG8_SA(1, 1), a1 + hstep, voffA);
            PG8_WAIT_V(8); PG8_WAIT_L(0); PG8_BAR; if (t == 0) { PG8_MMAX(0, 0, At, B0, true); PG8_MMAX(0, 1, At, B1, true); } else { PG8_MMA(0, 0, At, B0); PG8_MMA(0, 1, At, B1); } PG8_BAR; PG8_SCHED;
            PG8_LDA(At, 0, 1); PG8_STAGE(PG8_SB(0, 0), b2, voffB); PG8_STAGE(PG8_SB(0, 1), b2 + hstep, voffB); PG8_STAGE(PG8_SA(0, 0), a2, voffA);
            PG8_WAIT_V(8); PG8_WAIT_L(0); PG8_BAR; if (t == 0) { PG8_MMAX(1, 0, At, B0, true); PG8_MMAX(1, 1, At, B1, true); } else { PG8_MMA(1, 0, At, B0); PG8_MMA(1, 1, At, B1); } PG8_BAR; PG8_SCHED;
            PG8_LDB(B0, 1, 0); PG8_LDB(B1, 1, 1); PG8_SCHED; PG8_LDA(At, 1, 0); PG8_STAGE(PG8_SA(0, 1), a2 + hstep, voffA);
            PG8_WAIT_V(8); PG8_WAIT_L(0); PG8_BAR; PG8_MMA(0, 0, At, B0); PG8_MMA(0, 1, At, B1); PG8_BAR; PG8_SCHED;
            PG8_LDA(At, 1, 1); PG8_STAGE(PG8_SB(1, 0), b3, voffB); PG8_STAGE(PG8_SB(1, 1), b3 + hstep, voffB); PG8_STAGE(PG8_SA(1, 0), a3, voffA);
            PG8_WAIT_V(8); PG8_WAIT_L(0); PG8_BAR; PG8_MMA(1, 0, At, B0); PG8_MMA(1, 1, At, B1); PG8_BAR; PG8_SCHED;
            } else {
            PG8_LDB(B0, 0, 0); PG8_SCHED; PG8_LDA(At, 0, 0); PG8_STAGE(PG8_SA(1, 1), a1 + hstep, voffA);
            PG8_WAIT_L(8); PG8_BAR; PG8_WAIT_L(0); PG8_MMA(0, 0, At, B0); PG8_BAR; PG8_SCHED;
            PG8_LDB(B1, 0, 1); PG8_STAGE(PG8_SB(0, 0), b2, voffB);
            PG8_BAR; PG8_WAIT_L(0); PG8_MMA(0, 1, At, B1); PG8_BAR;
            PG8_LDA(At, 0, 1); PG8_STAGE(PG8_SA(0, 0), a2, voffA);
            PG8_BAR; PG8_WAIT_L(0); PG8_MMA(1, 0, At, B0); PG8_BAR; PG8_SCHED;
            PG8_STAGE(PG8_SB(0, 1), b2 + hstep, voffB);
            PG8_WAIT_V(6); PG8_BAR; PG8_MMA(1, 1, At, B1); PG8_BAR;
            PG8_LDB(B0, 1, 0); PG8_SCHED; PG8_LDA(At, 1, 0); PG8_STAGE(PG8_SA(0, 1), a2 + hstep, voffA);
            PG8_WAIT_L(8); PG8_BAR; PG8_WAIT_L(0); PG8_MMA(0, 0, At, B0); PG8_BAR; PG8_SCHED;
            PG8_LDB(B1, 1, 1); PG8_STAGE(PG8_SB(1, 0), b3, voffB);
            PG8_BAR; PG8_WAIT_L(0); PG8_MMA(0, 1, At, B1); PG8_BAR;
            PG8_LDA(At, 1, 1); PG8_STAGE(PG8_SA(1, 0), a3, voffA);
            PG8_BAR; PG8_WAIT_L(0); PG8_MMA(1, 0, At, B0); PG8_BAR; PG8_SCHED;
            PG8_STAGE(PG8_SB(1, 1), b3 + hstep, voffB);
            PG8_WAIT_V(6); PG8_BAR; PG8_MMA(1, 1, At, B1); PG8_BAR;
            }
        }
        if constexpr (ALIGN_EPI) { if (wr == 0) PG8_BAR; }
        if constexpr (!Epi::AFTER_DRAIN) { { int l2_ = (int)__builtin_amdgcn_mbcnt_hi(~0u, __builtin_amdgcn_mbcnt_lo(~0u, 0u)); asm volatile("" : "+v"(l2_)); if constexpr (Epi::RSP) E(acc, cur, wr, wc, l2_ & 15, l2_ >> 4, (const PG8_LAS unsigned char*)(lds + RSL_OFF + (ui & 1) * 2048)); else E(acc, cur, wr, wc, l2_ & 15, l2_ >> 4); } S.done(cur);     if constexpr (Epi::KEEPF) { _Pragma("unroll") for (int m_ = 0; m_ < 4; ++m_) _Pragma("unroll") for (int k_ = 0; k_ < 2; ++k_) asm volatile("" :: "v"(At[m_][k_])); _Pragma("unroll") for (int n_ = 0; n_ < 2; ++n_) _Pragma("unroll") for (int k_ = 0; k_ < 2; ++k_) asm volatile("" :: "v"(B0[n_][k_]), "v"(B1[n_][k_])); } }
        if (!has_next) break;
#pragma unroll
        for (int a = 0; a < 2; ++a)
#pragma unroll
            for (int b = 0; b < 2; ++b)
#pragma unroll
                for (int m = 0; m < 4; ++m)
#pragma unroll
                    for (int n = 0; n < 2; ++n) { if constexpr (!SP2) acc[a][b][m][n] = (f32x4){0.f, 0.f, 0.f, 0.f}; }
        cur = nxt; cA = nA; cB = nB; ++ui;
        if constexpr (ALIGN_EPI) { if (wr == 1) PG8_BAR; }
    }
    PG8_WAIT_V(0);
    if constexpr (!ALIGN_EPI) { if (wr == 0) PG8_BAR; }
    PG8_BAR;
    if constexpr (Epi::AFTER_DRAIN) { E.fused(acc, cur, wr, wc, fr, fq, lds, wid, lane); S.done(cur); }
#undef PG8_SA
#undef PG8_SB
#undef PG8_STAGE
#undef PG8_LDA
#undef PG8_LDB
#undef PG8_MMA
#undef PG8_WAIT_V
#undef PG8_WAIT_L
#undef PG8_BAR
#undef PG8_SCHED
}
}


constexpr int BATCH = 16, SEQ = 2048, D = 2048, M = BATCH * SEQ;
constexpr int NH = 16, DK = 128, DV = 128, CH = 64, NCH = SEQ / CH;
constexpr int DFF = 5632, NE = 8, DFFE = 7168;
constexpr int SROWS = 34816;
constexpr float EPS = 1e-6f;
constexpr float F8_SA = 16.f, F8_SW_UP = 512.f, F8_SH = 8.f, F8_SW_DN = 1024.f;
constexpr float I8_SA = 31.75f, I8_SA_X1 = 27.f, I8_SA_X2 = 24.f, I8_SW = 1437.f;
constexpr int NPH = 16;
#ifndef F8SP2
#define F8SP2 true
#endif
constexpr int NWAVES = 8;

constexpr size_t MiB = 1u << 20;
constexpr size_t WS_CTL = 0, CTL_ZERO_BYTES = 2 * MiB;
constexpr size_t WS_RSS1 = 1 * MiB, WS_RSS2 = WS_RSS1 + 256 * 1024, WS_LNST = WS_RSS2 + 256 * 1024;
static_assert(WS_LNST + 512 * 1024 <= CTL_ZERO_BYTES, "zeroed region");
constexpr size_t WS_SMALL = 2 * MiB;
constexpr size_t WS_RSS0 = WS_SMALL, WS_LB = WS_RSS0 + 128 * 1024, WS_TOKE = WS_LB + 8192, WS_TOKP = WS_TOKE + 256 * 1024, WS_TOKW = WS_TOKP + 256 * 1024, WS_TOKRS = WS_TOKW + 256 * 1024;
constexpr size_t WS_ROWTOK = WS_TOKRS + 128 * 1024, WS_ROWW = WS_ROWTOK + 2 * SROWS * 4, WS_ROWRS = WS_ROWW + 2 * SROWS * 4, WS_PANE = WS_ROWRS + 2 * SROWS * 4;
constexpr size_t WS_NPAN = WS_PANE + 2 * 160 * 4;
static_assert(WS_NPAN + 64 <= 6 * MiB, "small region");
constexpr size_t WS_W_HIN = 6 * MiB, WS_W_HOUT = WS_W_HIN + 32 * MiB, WS_W_FGU = WS_W_HOUT + 8 * MiB, WS_W_FD = WS_W_FGU + 44 * MiB, WS_W_SIN = WS_W_FD + 22 * MiB, WS_W_SOUT = WS_W_SIN + 16 * MiB;
constexpr size_t WS_W_MGU = WS_W_SOUT + 8 * MiB, WS_W_MD = WS_W_MGU + 448 * MiB, WS_XB = WS_W_MD + 224 * MiB, WS_R = WS_XB + 128 * MiB;
constexpr size_t R_Q = 0, R_K = 128 * MiB, R_G = 256 * MiB, R_I = 384 * MiB, R_GT = 512 * MiB;
constexpr size_t R_HFF = 0;
constexpr size_t R_U = 0, R_V = 128 * MiB;
constexpr size_t R_AS = 0, R_H = 272 * MiB, R_Y = 0;
constexpr size_t WS_YS = WS_R + 748 * MiB;
constexpr size_t WS_O = WS_R + 748 * MiB;
constexpr size_t WS_END = WS_O + 128 * MiB;
static_assert((size_t)SROWS * 2048 * 2 == 136 * MiB && (size_t)SROWS * 7168 * 2 == 476 * MiB, "expert buffers");
constexpr int CW_BAR = 4096;
constexpr int CW_CNT = 8192;

constexpr int LDS_BYTES = 147456;
constexpr int MISC_OFF = LDS_BYTES - 256;

#define GAS __attribute__((address_space(1)))
#define LAS __attribute__((address_space(3)))
typedef unsigned short bf16;
typedef unsigned v4u __attribute__((ext_vector_type(4)));
typedef unsigned v2u __attribute__((ext_vector_type(2)));
typedef float f32x4 __attribute__((ext_vector_type(4)));
typedef float f32x16 __attribute__((ext_vector_type(16)));
typedef short bf16x8 __attribute__((ext_vector_type(8)));
#define LDS_WAIT() asm volatile("s_waitcnt lgkmcnt(0)" ::: "memory")
#define VM_WAIT() asm volatile("s_waitcnt vmcnt(0)" ::: "memory")
#define WG_BAR() do { asm volatile("s_waitcnt lgkmcnt(0)" ::: "memory"); __builtin_amdgcn_s_barrier(); asm volatile("" ::: "memory"); } while (0)
__device__ __forceinline__ unsigned pk2(float lo, float hi) { return pg8::cvt_pk_bf16(lo, hi); }
__device__ __forceinline__ unsigned f2bf(float f) { return pg8::cvt_pk_bf16(f, 0.f) & 0xffffu; }
__device__ __forceinline__ float bf2f(unsigned short b) { return __builtin_bit_cast(float, (unsigned)b << 16); }
__device__ __forceinline__ float bflo(unsigned w) { return __builtin_bit_cast(float, w << 16); }
__device__ __forceinline__ float bfhi(unsigned w) { return __builtin_bit_cast(float, w & 0xffff0000u); }
__device__ __forceinline__ float wave_sum(float v) {
#pragma unroll
    for (int o = 1; o < 64; o <<= 1) v += __shfl_xor(v, o);
    return v;
}

#define XB_TMO      128
#define XB_XCNT(j)  (256  + 64 * (j))
#define XB_XSUB(j)  (1280 + 64 * (j))
#define XB_XGEN(j)  (2304 + 64 * (j))
#define XB_TOP      3328
#define XB_TOPGEN   3392
#define XCD_BAR_WORDS 3456
#define XB_SPIN_CAP (1u << 24)
__device__ __forceinline__ unsigned xb_ld(unsigned* p)              { return __hip_atomic_load(p, __ATOMIC_RELAXED, __HIP_MEMORY_SCOPE_AGENT); }
__device__ __forceinline__ unsigned xb_add(unsigned* p, unsigned v) { return __hip_atomic_fetch_add(p, v, __ATOMIC_RELAXED, __HIP_MEMORY_SCOPE_AGENT); }
__device__ __forceinline__ unsigned xb_xcc_id() { return (unsigned)__builtin_amdgcn_s_getreg((3 << 11) | 20) & 0xFu; }
#define XB_SPIN(cond, bar) do { unsigned _sp = 0; while (cond) { __builtin_amdgcn_s_sleep(1); \
    if ((++_sp & 255u) == 0u) { if (xb_ld(&(bar)[XB_TMO])) break; if (_sp > XB_SPIN_CAP) { atomicAdd(&(bar)[XB_TMO], 1u); break; } } } } while (0)
struct XcdBarrier { unsigned* bar; unsigned x; volatile LAS unsigned* st; };
__device__ __forceinline__ XcdBarrier xcd_barrier_post(unsigned* bar, volatile LAS unsigned* st) {
    XcdBarrier b; b.bar = bar; b.x = xb_xcc_id(); b.st = st;
    if (threadIdx.x == 0) (void)xb_add(&bar[XB_XCNT(b.x)], 1u);
    return b;
}
__device__ __forceinline__ void xcd_barrier_complete(unsigned* bar, unsigned x, unsigned& nloc, unsigned& nx) {
    const unsigned G = gridDim.x * gridDim.y * gridDim.z;
    unsigned sum, cnt, mine, sp = 0u;
    for (;;) {
        sum = 0u; cnt = 0u; mine = 0u;
#pragma unroll
        for (unsigned j = 0; j < 16; ++j) { const unsigned c = xb_ld(&bar[XB_XCNT(j)]); sum += c; cnt += (c > 0u) ? 1u : 0u; mine = (j == x) ? c : mine; }
        if (sum == G) break;
        __builtin_amdgcn_s_sleep(1);
        if ((++sp & 255u) == 0u) { if (xb_ld(&bar[XB_TMO])) break; if (sp > XB_SPIN_CAP) { atomicAdd(&bar[XB_TMO], 1u); break; } }
    }
    nloc = mine > 0u ? mine : 1u; nx = cnt > 0u ? cnt : 1u;
}
__device__ __forceinline__ void xcd_barrier(const XcdBarrier& b) {
    asm volatile("s_waitcnt vmcnt(0)" ::: "memory");
    __syncthreads();
    if (threadIdx.x == 0) {
        unsigned* bar = b.bar;
        __builtin_amdgcn_s_waitcnt(0);
        unsigned nloc = b.st[0], nx = b.st[1];
        if (nloc == 0u) { xcd_barrier_complete(bar, b.x, nloc, nx); b.st[0] = nloc; b.st[1] = nx; }
        const unsigned old = xb_add(&bar[XB_XSUB(b.x)], 1u);
        const unsigned gen = old / nloc;
        if (old + 1u == (gen + 1u) * nloc) {
            __builtin_amdgcn_fence(__ATOMIC_RELEASE, "agent");
            asm volatile("s_waitcnt vmcnt(0)" ::: "memory");
            const unsigned og = xb_add(&bar[XB_TOP], 1u);
            const unsigned tg = og / nx;
            if (og + 1u == (tg + 1u) * nx) xb_add(&bar[XB_TOPGEN], 1u);
            else XB_SPIN(xb_ld(&bar[XB_TOPGEN]) == tg, bar);
            __builtin_amdgcn_fence(__ATOMIC_ACQUIRE, "agent");
            xb_add(&bar[XB_XGEN(b.x)], 1u);
            asm volatile("s_waitcnt vmcnt(0)" ::: "memory");
        } else {
            XB_SPIN(xb_ld(&bar[XB_XGEN(b.x)]) == gen, bar);
            __builtin_amdgcn_fence(__ATOMIC_ACQUIRE, "agent");
            asm volatile("s_waitcnt vmcnt(0)" ::: "memory");
        }
    }
    __syncthreads();
}

struct Args { const float* in[23]; float* out; unsigned char* ws; int ph_lo, ph_hi; };


struct TrDesc { const float* src; const float* gain; unsigned char* dst; int N, dpitch, k0, n0, mode, f8; float scale; };
constexpr int TR_HIN = 16 * 256, TR_HOUT = 16 * 64, TR_FG = 16 * 176, TR_FD = 44 * 64, TR_SIN = 16 * 128, TR_SOUT = 16 * 64, TR_MG = 16 * 224, TR_MD = 56 * 64;
constexpr int TR_NITEMS = TR_HIN + TR_HOUT + 2 * TR_FG + TR_FD + TR_SIN + TR_SOUT + 8 * (2 * TR_MG + TR_MD);
__device__ __forceinline__ void tr_set(TrDesc& d, const float* W, int K, int N, const float* gain, unsigned char* dst, int mode, int f8, float scale, int item) {
    const int nblk = N / 32, kb = item / nblk, nb = item - kb * nblk;
    d.src = W; d.gain = gain; d.dst = dst; d.N = N; d.dpitch = f8 ? K : 2 * K; d.k0 = 128 * kb; d.n0 = 32 * nb; d.mode = mode; d.f8 = f8; d.scale = scale;
}
__device__ __forceinline__ void tr_desc(const Args& a, int it, TrDesc& d) {
    unsigned char* ws = a.ws; int r = it;
    if (r < TR_HIN) { tr_set(d, a.in[3], 2048, 8192, a.in[2], ws + WS_W_HIN, 0, 2, I8_SW, r); return; } r -= TR_HIN;
    if (r < TR_HOUT) { tr_set(d, a.in[5], 2048, 2048, nullptr, ws + WS_W_HOUT, 0, 0, 1.f, r); return; } r -= TR_HOUT;
    if (r < TR_FG) { tr_set(d, a.in[7], 2048, DFF, a.in[6], ws + WS_W_FGU, 1, 2, I8_SW, r); return; } r -= TR_FG;
    if (r < TR_FG) { tr_set(d, a.in[8], 2048, DFF, a.in[6], ws + WS_W_FGU, 2, 2, I8_SW, r); return; } r -= TR_FG;
    if (r < TR_FD) { tr_set(d, a.in[9], DFF, 2048, nullptr, ws + WS_W_FD, 0, 0, 1.f, r); return; } r -= TR_FD;
    if (r < TR_SIN) { tr_set(d, a.in[11], 2048, 4096, a.in[10], ws + WS_W_SIN, 0, 2, I8_SW, r); return; } r -= TR_SIN;
    if (r < TR_SOUT) { tr_set(d, a.in[16], 2048, 2048, nullptr, ws + WS_W_SOUT, 0, 0, 1.f, r); return; } r -= TR_SOUT;
    if (r < 8 * TR_MG) { const int e = r / TR_MG; tr_set(d, a.in[19] + (size_t)e * 2048 * DFFE, 2048, DFFE, a.in[17], ws + WS_W_MGU + (size_t)e * 2 * DFFE * 2048, 1, 1, F8_SW_UP, r - e * TR_MG); return; } r -= 8 * TR_MG;
    if (r < 8 * TR_MG) { const int e = r / TR_MG; tr_set(d, a.in[20] + (size_t)e * 2048 * DFFE, 2048, DFFE, a.in[17], ws + WS_W_MGU + (size_t)e * 2 * DFFE * 2048, 2, 1, F8_SW_UP, r - e * TR_MG); return; } r -= 8 * TR_MG;
    { const int e = r / TR_MD; tr_set(d, a.in[21] + (size_t)e * DFFE * 2048, DFFE, 2048, nullptr, ws + WS_W_MD + (size_t)e * 2048 * DFFE, 0, 1, F8_SW_DN, r - e * TR_MD); }
}
__device__ __forceinline__ void tr_load(const TrDesc& d, f32x4 (&v)[16], float (&g)[16], int lane) {
    const int r = lane >> 3, c4 = lane & 7; const float* base = d.src + (size_t)(d.k0 + r) * d.N + d.n0 + 4 * c4; const size_t step = (size_t)8 * d.N;
#pragma unroll
    for (int i = 0; i < 16; ++i) v[i] = __builtin_nontemporal_load((const f32x4*)(base + i * step));
#pragma unroll
    for (int i = 0; i < 16; ++i) g[i] = d.gain ? d.gain[d.k0 + 8 * i + r] : 1.f;
}
__device__ __forceinline__ void tr_process(const TrDesc& d, const f32x4 (&v)[16], const float (&g)[16], LAS float* scr, int lane) {
    { const int r = lane >> 3, c4 = lane & 7;
#pragma unroll
      for (int i = 0; i < 16; ++i) { const float s = g[i] * d.scale; LAS float* p = scr + (8 * i + r) * 33 + 4 * c4; p[0] = v[i].x * s; p[1] = v[i].y * s; p[2] = v[i].z * s; p[3] = v[i].w * s; } }
    LDS_WAIT(); asm volatile("" ::: "memory");
    const int c = lane & 15, nn = lane >> 4;
#pragma unroll
    for (int t = 0; t < 8; ++t) { const int n = nn + 4 * t; const LAS float* s = scr + (8 * c) * 33 + n;
        const int gn = d.n0 + n; const int row = d.mode == 0 ? gn : (gn >> 7) * 256 + (d.mode - 1) * 128 + (gn & 127);
        unsigned char* o = d.dst + (size_t)row * d.dpitch;
        if (d.f8 == 2) { v2u w; w.x = pg8::pk4_i8(s[0 * 33], s[1 * 33], s[2 * 33], s[3 * 33]); w.y = pg8::pk4_i8(s[4 * 33], s[5 * 33], s[6 * 33], s[7 * 33]); *(v2u*)(o + d.k0 + 8 * c) = w; }
        else if (d.f8) { v2u w; w.x = pg8::pk4_fp8(s[0 * 33], s[1 * 33], s[2 * 33], s[3 * 33]); w.y = pg8::pk4_fp8(s[4 * 33], s[5 * 33], s[6 * 33], s[7 * 33]); *(v2u*)(o + d.k0 + 8 * c) = w; }
        else { v4u w; w.x = pk2(s[0 * 33], s[1 * 33]); w.y = pk2(s[2 * 33], s[3 * 33]); w.z = pk2(s[4 * 33], s[5 * 33]); w.w = pk2(s[6 * 33], s[7 * 33]); *(v4u*)(o + 2 * (d.k0 + 8 * c)) = w; } }
    asm volatile("" ::: "memory");
}

__device__ __forceinline__ void p0_prologue(const Args& a, LAS unsigned char* lds, int vcu, int G, int wave, int lane) {
    unsigned char* ws = a.ws;
    LAS float* scr = (LAS float*)(lds + wave * 16896);
    const int gw = vcu * NWAVES + wave, NGW = G * NWAVES;
    { const float* x = a.in[0]; unsigned char* xq = ws + WS_R + 128 * MiB;
      for (int m = gw; m < M; m += NGW) {
          const f32x4* xr = (const f32x4*)(x + (size_t)m * D) + 2 * lane; f32x4 v[8]; float s = 0.f;
#pragma unroll
          for (int q = 0; q < 4; ++q) { v[2 * q] = xr[128 * q]; v[2 * q + 1] = xr[128 * q + 1];
              s += ((v[2 * q].x * v[2 * q].x + v[2 * q].y * v[2 * q].y) + (v[2 * q].z * v[2 * q].z + v[2 * q].w * v[2 * q].w)) + ((v[2 * q + 1].x * v[2 * q + 1].x + v[2 * q + 1].y * v[2 * q + 1].y) + (v[2 * q + 1].z * v[2 * q + 1].z + v[2 * q + 1].w * v[2 * q + 1].w)); }
          const float sc = I8_SA / sqrtf(wave_sum(s) * (1.0f / 2048.0f) + EPS);
          v2u* o = (v2u*)(xq + (size_t)m * D) + lane;
#pragma unroll
          for (int q = 0; q < 4; ++q) o[64 * q] = (v2u){pg8::pk4_i8(v[2 * q].x * sc, v[2 * q].y * sc, v[2 * q].z * sc, v[2 * q].w * sc), pg8::pk4_i8(v[2 * q + 1].x * sc, v[2 * q + 1].y * sc, v[2 * q + 1].z * sc, v[2 * q + 1].w * sc)}; } }
    { const float* lg = a.in[1]; float* lb = (float*)(ws + WS_LB);
      for (int c = gw * 64 + lane; c < 2048; c += NGW * 64) { const float l0 = lg[c], l1 = lg[2048 + c], l2 = lg[4096 + c], mx = fmaxf(l0, fmaxf(l1, l2));
          const float e0 = __expf(l0 - mx), e1 = __expf(l1 - mx), e2 = __expf(l2 - mx); lb[c] = e0 / (e0 + e1 + e2); }
      int* rt = (int*)(ws + WS_ROWTOK); float* rw = (float*)(ws + WS_ROWW); float* rr = (float*)(ws + WS_ROWRS);
      for (int i = gw * 64 + lane; i < 2 * SROWS; i += NGW * 64) { rt[i] = -1; rw[i] = 0.f; rr[i] = 0.f; } }
    TrDesc cur, nxt; f32x4 cv[16], nv[16]; float cg[16], ng[16];
    int it = gw; bool have = it < TR_NITEMS;
    if (have) { tr_desc(a, it, cur); tr_load(cur, cv, cg, lane); }
    while (have) {
        const int itn = it + NGW; const bool hn = itn < TR_NITEMS;
        if (hn) { tr_desc(a, itn, nxt); tr_load(nxt, nv, ng, lane); }
        tr_process(cur, cv, cg, scr, lane);
        cur = nxt; it = itn; have = hn;
#pragma unroll
        for (int i = 0; i < 16; ++i) { cv[i] = nv[i]; cg[i] = ng[i]; }
    }
}

#define MFMA32(a, b, c) __builtin_amdgcn_mfma_f32_32x32x16_bf16((a), (b), (c), 0, 0, 0)
template <int KSTEPS> __device__ __forceinline__ void mma_img(f32x16& acc, const LAS unsigned char* A, int pa, int m0, const LAS unsigned char* B, int pb, int n0, int lane) {
    const int r = lane & 31, h = lane >> 5; const LAS unsigned char* ap = A + (m0 + r) * pa + 16 * h; const LAS unsigned char* bp = B + (n0 + r) * pb + 16 * h;
#pragma unroll
    for (int s = 0; s < KSTEPS; ++s) { const bf16x8 av = *(const LAS bf16x8*)(ap + 32 * s), bv = *(const LAS bf16x8*)(bp + 32 * s); acc = MFMA32(av, bv, acc); }
}
constexpr int SC_P128 = 272, SC_P64 = 144;
constexpr int SC_KI = 0, SC_QI = 17408, SC_QE = 34816, SC_ST = 52224, SC_VT = 87040, SC_KST = 105472, SC_P = 123904, SC_DEC = 133120, SC_CSUM = 133632  , SC_RED = 137728, SC_NG = 138752, SC_END = 139264;
static_assert(SC_END <= MISC_OFF, "scan LDS");

__device__ __forceinline__ void hgrn_scan_unit(LAS unsigned char* lds, int bh, const bf16* Qg, const bf16* Kg, const bf16* Gg, const bf16* Ig, const bf16* Gtg, bf16* Og, const float* normg, int tid) {
    const int lane = tid & 63, wave = tid >> 6, b = bh >> 4, hh = bh & 15;
    const int r = lane & 31, h2 = lane >> 5;
    const size_t gbase = (size_t)b * SEQ * 2048 + hh * 128;
    for (int i = tid; i < 34816 / 16; i += 512) *(LAS v4u*)(lds + SC_ST + 16 * i) = (v4u){0u, 0u, 0u, 0u};
    if (tid < 128) ((LAS float*)(lds + SC_NG))[tid] = normg[hh * 128 + tid];
    f32x16 S0, S1;
#pragma unroll
    for (int i = 0; i < 16; ++i) { S0[i] = 0.f; S1[i] = 0.f; }
    const int dkp = tid & 63, dk0 = 2 * dkp, tq8 = wave;
    unsigned cq[8], cg[8], cv[8];
    { const size_t o = gbase + (size_t)(8 * tq8) * 2048 + dk0;
#pragma unroll
      for (int i = 0; i < 8; ++i) { cq[i] = *(const unsigned*)(Qg + o + (size_t)i * 2048); cg[i] = *(const unsigned*)(Gg + o + (size_t)i * 2048); cv[i] = *(const unsigned*)(Ig + o + (size_t)i * 2048); } }
    WG_BAR();
    for (int c = 0; c < NCH; ++c) {
        unsigned nq[8], ng[8], nv[8];
        { const int cn = (c + 1 < NCH) ? c + 1 : c; const size_t o = gbase + (size_t)(64 * cn + 8 * tq8) * 2048 + dk0;
#pragma unroll
          for (int i = 0; i < 8; ++i) { nq[i] = *(const unsigned*)(Qg + o + (size_t)i * 2048); ng[i] = *(const unsigned*)(Gg + o + (size_t)i * 2048); nv[i] = *(const unsigned*)(Ig + o + (size_t)i * 2048); } }
        v2u gtv[4];
        { const size_t orow_ = gbase + (size_t)(64 * c + 32 * (wave & 1) + r) * 2048 + 32 * (wave >> 1) + 4 * h2;
#pragma unroll
          for (int g4 = 0; g4 < 4; ++g4) gtv[g4] = *(const v2u*)(Gtg + orow_ + 8 * g4); }
        float bl0[8], bl1[8]; { float r0 = 0.f, r1 = 0.f;
#pragma unroll
          for (int i = 0; i < 8; ++i) { r0 += bflo(cg[i]); r1 += bfhi(cg[i]); bl0[i] = r0; bl1[i] = r1; }
          *(LAS pg8::f32x2*)(lds + SC_CSUM + 4 * (tq8 * 128 + dk0)) = (pg8::f32x2){r0, r1}; }
        WG_BAR();
        { float pre0 = 0.f, pre1 = 0.f, mid0 = 0.f, mid1 = 0.f, tot0 = 0.f, tot1 = 0.f;
#pragma unroll
          for (int q8 = 0; q8 < 8; ++q8) { const pg8::f32x2 cs = *(const LAS pg8::f32x2*)(lds + SC_CSUM + 4 * (q8 * 128 + dk0));
              if (q8 < tq8) { pre0 += cs.x; pre1 += cs.y; } if (q8 < 4) { mid0 += cs.x; mid1 += cs.y; } tot0 += cs.x; tot1 += cs.y; }
          const float A10 = __expf(-mid0), A11 = __expf(-mid1), A20 = __expf(mid0), A21 = __expf(mid1), Dc0 = __expf(tot0), Dc1 = __expf(tot1);
          if (tq8 == 0) *(LAS pg8::f32x2*)(lds + SC_DEC + 4 * dk0) = (pg8::f32x2){Dc0, Dc1};
          float ks0[8], ks1[8];
#pragma unroll
          for (int i = 0; i < 8; ++i) {
              const int t = 8 * tq8 + i;
              const float E0 = __expf(fmaxf(pre0 + bl0[i], -80.f)), E1 = __expf(fmaxf(pre1 + bl1[i], -80.f)), rE0 = __builtin_amdgcn_rcpf(E0), rE1 = __builtin_amdgcn_rcpf(E1);
              const float q0 = bflo(cq[i]), q1 = bfhi(cq[i]), k0 = 1.0f - __expf(bflo(cg[i])), k1 = 1.0f - __expf(bfhi(cg[i]));
              const float qe0 = q0 * E0, qe1 = q1 * E1, kr0 = k0 * rE0, kr1 = k1 * rE1;
              *(LAS unsigned*)(lds + SC_QI + t * SC_P128 + 4 * dkp) = pk2(qe0 * A10, qe1 * A11);
              *(LAS unsigned*)(lds + SC_KI + t * SC_P128 + 4 * dkp) = pk2(kr0 * A20, kr1 * A21);
              *(LAS unsigned*)(lds + SC_QE + t * SC_P128 + 4 * dkp) = pk2(qe0, qe1);
              ks0[i] = kr0 * Dc0; ks1[i] = kr1 * Dc1; }
          *(LAS v4u*)(lds + SC_KST + dk0 * SC_P64 + 16 * tq8) = (v4u){pk2(ks0[0], ks0[1]), pk2(ks0[2], ks0[3]), pk2(ks0[4], ks0[5]), pk2(ks0[6], ks0[7])};
          *(LAS v4u*)(lds + SC_KST + (dk0 + 1) * SC_P64 + 16 * tq8) = (v4u){pk2(ks1[0], ks1[1]), pk2(ks1[2], ks1[3]), pk2(ks1[4], ks1[5]), pk2(ks1[6], ks1[7])};
          *(LAS v4u*)(lds + SC_VT + dk0 * SC_P64 + 16 * tq8) = (v4u){(cv[0] & 0xffffu) | (cv[1] << 16), (cv[2] & 0xffffu) | (cv[3] << 16), (cv[4] & 0xffffu) | (cv[5] << 16), (cv[6] & 0xffffu) | (cv[7] << 16)};
          *(LAS v4u*)(lds + SC_VT + (dk0 + 1) * SC_P64 + 16 * tq8) = (v4u){(cv[0] >> 16) | (cv[1] & 0xffff0000u), (cv[2] >> 16) | (cv[3] & 0xffff0000u), (cv[4] >> 16) | (cv[5] & 0xffff0000u), (cv[6] >> 16) | (cv[7] & 0xffff0000u)}; }
        WG_BAR();
        const int dm = wave >> 1, tn = wave & 1;
        f32x16 oacc;
#pragma unroll
        for (int i = 0; i < 16; ++i) oacc[i] = 0.f;
        mma_img<8>(oacc, lds + SC_ST, SC_P128, 32 * dm, lds + SC_QE, SC_P128, 32 * tn, lane);
        if (wave < 4) {
            const int sm = wave >> 1, xn = wave & 1; f32x16 x;
#pragma unroll
            for (int i = 0; i < 16; ++i) x[i] = 0.f;
            mma_img<8>(x, lds + SC_KI, SC_P128, 32 * sm, lds + SC_QI, SC_P128, 32 * xn, lane);
            const int t = 32 * xn + r;
#pragma unroll
            for (int g4 = 0; g4 < 4; ++g4) { const int s0 = 32 * sm + 8 * g4 + 4 * h2; float v[4];
#pragma unroll
                for (int j = 0; j < 4; ++j) v[j] = (t >= s0 + j) ? x[4 * g4 + j] : 0.f;
                *(LAS v2u*)(lds + SC_P + t * SC_P64 + 2 * s0) = (v2u){pk2(v[0], v[1]), pk2(v[2], v[3])}; }
        }
        WG_BAR();
        mma_img<4>(oacc, lds + SC_VT, SC_P64, 32 * dm, lds + SC_P, SC_P64, 32 * tn, lane);
        { const int km = wave >> 1, vn0 = 2 * (wave & 1);
#pragma unroll
          for (int g4 = 0; g4 < 4; ++g4) { const f32x4 dc = *(const LAS f32x4*)(lds + SC_DEC + 4 * (32 * km + 8 * g4 + 4 * h2));
#pragma unroll
              for (int j = 0; j < 4; ++j) { S0[4 * g4 + j] *= dc[j]; S1[4 * g4 + j] *= dc[j]; } }
          mma_img<4>(S0, lds + SC_KST, SC_P64, 32 * km, lds + SC_VT, SC_P64, 32 * vn0, lane);
          mma_img<4>(S1, lds + SC_KST, SC_P64, 32 * km, lds + SC_VT, SC_P64, 32 * (vn0 + 1), lane); }
        { float ss = 0.f;
#pragma unroll
          for (int i = 0; i < 16; ++i) ss += oacc[i] * oacc[i];
          ss += __shfl_xor(ss, 32);
          if (h2 == 0) ((LAS float*)(lds + SC_RED))[dm * 64 + 32 * tn + r] = ss; }
        WG_BAR();
        { const int km = wave >> 1, vn0 = 2 * (wave & 1);
#pragma unroll
          for (int g4 = 0; g4 < 4; ++g4) { const int dk0 = 32 * km + 8 * g4 + 4 * h2;
              *(LAS v2u*)(lds + SC_ST + (32 * vn0 + r) * SC_P128 + 2 * dk0) = (v2u){pk2(S0[4 * g4], S0[4 * g4 + 1]), pk2(S0[4 * g4 + 2], S0[4 * g4 + 3])};
              *(LAS v2u*)(lds + SC_ST + (32 * (vn0 + 1) + r) * SC_P128 + 2 * dk0) = (v2u){pk2(S1[4 * g4], S1[4 * g4 + 1]), pk2(S1[4 * g4 + 2], S1[4 * g4 + 3])}; } }
        { const int t = 32 * tn + r; const LAS float* rd = (const LAS float*)(lds + SC_RED);
          const float tot = (rd[t] + rd[64 + t]) + (rd[128 + t] + rd[192 + t]), rinv = 1.0f / sqrtf(tot * (1.0f / 128.0f) + EPS);
          const size_t orow = gbase + (size_t)(64 * c + t) * 2048;
#pragma unroll
          for (int g4 = 0; g4 < 4; ++g4) { const int dv0 = 32 * dm + 8 * g4 + 4 * h2;
              const f32x4 ng4 = *(const LAS f32x4*)(lds + SC_NG + 4 * dv0); const v2u gt = gtv[g4];
              const float o0 = oacc[4 * g4] * rinv * ng4[0] * bflo(gt.x), o1 = oacc[4 * g4 + 1] * rinv * ng4[1] * bfhi(gt.x), o2 = oacc[4 * g4 + 2] * rinv * ng4[2] * bflo(gt.y), o3 = oacc[4 * g4 + 3] * rinv * ng4[3] * bfhi(gt.y);
              *(v2u*)(Og + orow + dv0) = (v2u){pk2(o0, o1), pk2(o2, o3)}; } }
#pragma unroll
        for (int i = 0; i < 8; ++i) { cq[i] = nq[i]; cg[i] = ng[i]; cv[i] = nv[i]; }
        WG_BAR();
    }
}

constexpr int SG_WM = 0, SG_VT = 34816, SG_MR = 69632, SG_END = 70656;
__device__ __forceinline__ void sgu_load_wm(LAS unsigned char* lds, const float* ws_g, int tid) {
    for (int i = tid; i < 128 * 32; i += 512) { const int t = i >> 5, s4 = (i & 31) * 4; f32x4 w = *(const f32x4*)(ws_g + t * 128 + s4);
        if (t < 64 && s4 >= 64) w = (f32x4){0.f, 0.f, 0.f, 0.f};
        *(LAS v2u*)(lds + SG_WM + t * SC_P128 + 2 * s4) = (v2u){pk2(w[0], w[1]), pk2(w[2], w[3])}; }
}
struct SguPre { unsigned raw[16]; float s1, s2; };
__device__ __forceinline__ void sgu_load(const bf16* V, const pg8::u64* stats, int bn, int g, int tid, SguPre& p) {
    const int cp = tid & 63, sq = tid >> 6; const bf16* vp = V + ((size_t)bn * 128 + 16 * sq) * 2048 + 128 * g + 2 * cp;
#pragma unroll
    for (int i = 0; i < 16; ++i) p.raw[i] = *(const unsigned*)(vp + (size_t)i * 2048);
    p.s1 = 0.f; p.s2 = 0.f;
    if (tid < 128) { p.s1 = pg8::fx_get(stats + 2 * ((size_t)bn * 128 + tid)); p.s2 = pg8::fx_get(stats + 2 * ((size_t)bn * 128 + tid) + 1); }
}
__device__ __forceinline__ void sgu_unit(LAS unsigned char* lds, int bn, int g, const bf16* U, bf16* Uo, const SguPre& cur, const bf16* V, const pg8::u64* stats, int nbn, int ng, SguPre& nxt,
                                         pg8::f32x2 gg, pg8::f32x2 bb, float bias0, float bias1, int tid) {
    const int lane = tid & 63, wave = tid >> 6, r = lane & 31, h2 = lane >> 5;
    const size_t row0 = (size_t)bn * 128;
    if (tid < 128) { const float mean = cur.s1 * (1.0f / 2048.0f), var = fmaxf(cur.s2 * (1.0f / 2048.0f) - mean * mean, 0.f);
        ((LAS float*)(lds + SG_MR))[2 * tid] = mean; ((LAS float*)(lds + SG_MR))[2 * tid + 1] = 1.0f / sqrtf(var + EPS); }
    WG_BAR();
    { const int cp = tid & 63, sq = tid >> 6, c0 = 2 * cp;
      unsigned pk0[8], pk1[8];
#pragma unroll
      for (int i = 0; i < 16; i += 2) { const int s = 16 * sq + i; const pg8::f32x4 mr = *(const LAS pg8::f32x4*)(lds + SG_MR + 8 * s);
          const float a0 = (bflo(cur.raw[i]) - mr[0]) * mr[1] * gg.x + bb.x, a1 = (bflo(cur.raw[i + 1]) - mr[2]) * mr[3] * gg.x + bb.x;
          const float b0 = (bfhi(cur.raw[i]) - mr[0]) * mr[1] * gg.y + bb.y, b1 = (bfhi(cur.raw[i + 1]) - mr[2]) * mr[3] * gg.y + bb.y;
          pk0[i >> 1] = pk2(a0, a1); pk1[i >> 1] = pk2(b0, b1); }
      *(LAS v4u*)(lds + SG_VT + c0 * SC_P128 + 32 * sq) = (v4u){pk0[0], pk0[1], pk0[2], pk0[3]};
      *(LAS v4u*)(lds + SG_VT + c0 * SC_P128 + 32 * sq + 16) = (v4u){pk0[4], pk0[5], pk0[6], pk0[7]};
      *(LAS v4u*)(lds + SG_VT + (c0 + 1) * SC_P128 + 32 * sq) = (v4u){pk1[0], pk1[1], pk1[2], pk1[3]};
      *(LAS v4u*)(lds + SG_VT + (c0 + 1) * SC_P128 + 32 * sq + 16) = (v4u){pk1[4], pk1[5], pk1[6], pk1[7]}; }
    WG_BAR();
    sgu_load(V, stats, nbn, ng, tid, nxt);
    const int cm = wave >> 1;
#pragma unroll
    for (int jj = 0; jj < 2; ++jj) { const int tn = 2 * (wave & 1) + jj; f32x16 acc;
#pragma unroll
        for (int i = 0; i < 16; ++i) acc[i] = 0.f;
        mma_img<8>(acc, lds + SG_VT, SC_P128, 32 * cm, lds + SG_WM, SC_P128, 32 * tn, lane);
        const int t = 32 * tn + r; const float bias = jj ? bias1 : bias0; const bf16* up = U + (row0 + t) * 2048 + 128 * g; bf16* uo = Uo + (row0 + t) * 2048 + 128 * g;
#pragma unroll
        for (int g4 = 0; g4 < 4; ++g4) { const int c0 = 32 * cm + 8 * g4 + 4 * h2; const v2u uu = *(const v2u*)(up + c0);
            const float o0 = (acc[4 * g4] + bias) * bflo(uu.x), o1 = (acc[4 * g4 + 1] + bias) * bfhi(uu.x), o2 = (acc[4 * g4 + 2] + bias) * bflo(uu.y), o3 = (acc[4 * g4 + 3] + bias) * bfhi(uu.y);
            *(v2u*)(uo + c0) = (v2u){pk2(o0, o1), pk2(o2, o3)}; } }
    WG_BAR();
}

constexpr int RT_W = 0, RT_LCNT = 65536, RT_BASE = RT_LCNT + 64, RT_E = RT_BASE + 64, RT_LP = RT_E + 1024, RT_END = RT_LP + 1024;
__device__ __forceinline__ void router_phase(const Args& a, LAS unsigned char* lds, int G, int tid) {
    unsigned char* ws = a.ws; const int lane = tid & 63, wave = tid >> 6;
    const bf16* x2 = (const bf16*)(ws + WS_XB);     unsigned char* xb8 = ws + WS_R + R_H;     const float* gain = a.in[17]; const float* wr = a.in[18];
    unsigned* gcnt = (unsigned*)(ws + WS_CTL) + CW_CNT;
    int* tok_e = (int*)(ws + WS_TOKE); int* tok_p = (int*)(ws + WS_TOKP); float* tok_w = (float*)(ws + WS_TOKW); float* tok_rs = (float*)(ws + WS_TOKRS);
    LAS float* wrT = (LAS float*)(lds + RT_W); LAS int* lcnt = (LAS int*)(lds + RT_LCNT); LAS int* lbase = (LAS int*)(lds + RT_BASE); LAS int* le = (LAS int*)(lds + RT_E); LAS int* lp = (LAS int*)(lds + RT_LP);
    for (int i = tid; i < 2048 * 8; i += 512) { const int k = i >> 3, e = i & 7; wrT[e * 2048 + k] = wr[i] * gain[k]; }
    if (tid < 16) lcnt[tid] = 0;
    WG_BAR();
    for (int t0 = blockIdx.x * 128; t0 < M; t0 += G * 128) {
        v2u nx[8];
        { const int t = t0 + wave * 16; const v2u* xr = (const v2u*)(x2 + (size_t)t * D) + lane;
#pragma unroll
          for (int jj = 0; jj < 8; ++jj) nx[jj] = xr[64 * jj]; }
        for (int j = 0; j < 16; ++j) {
            const int ti = wave * 16 + j, t = t0 + ti;
            float acc[8], ss = 0.f; f32x4 xa[8];
#pragma unroll
            for (int jj = 0; jj < 8; ++jj) { const v2u xq = nx[jj]; xa[jj] = (f32x4){bflo(xq.x), bfhi(xq.x), bflo(xq.y), bfhi(xq.y)}; }
            { const int tn = t0 + wave * 16 + (j < 15 ? j + 1 : j); const v2u* xr = (const v2u*)(x2 + (size_t)tn * D) + lane;
#pragma unroll
              for (int jj = 0; jj < 8; ++jj) nx[jj] = xr[64 * jj]; }
#pragma unroll
            for (int e = 0; e < 8; ++e) acc[e] = 0.f;
#pragma unroll
            for (int jj = 0; jj < 8; ++jj) { const f32x4 xv = xa[jj]; ss += (xv.x * xv.x + xv.y * xv.y) + (xv.z * xv.z + xv.w * xv.w);
#pragma unroll
                for (int e = 0; e < 8; ++e) { const f32x4 w4 = *(const LAS f32x4*)(wrT + e * 2048 + 4 * lane + 256 * jj); acc[e] += (xv.x * w4.x + xv.y * w4.y) + (xv.z * w4.z + xv.w * w4.w); } }
            ss = wave_sum(ss);
#pragma unroll
            for (int e = 0; e < 8; ++e) acc[e] = wave_sum(acc[e]);
            const float rs = 1.0f / sqrtf(ss * (1.0f / 2048.0f) + EPS);
            { const float sc = rs * F8_SA; unsigned* dst = (unsigned*)(xb8 + (size_t)t * D) + lane;
#pragma unroll
              for (int jj = 0; jj < 8; ++jj) dst[64 * jj] = pg8::pk4_fp8(xa[jj].x * sc, xa[jj].y * sc, xa[jj].z * sc, xa[jj].w * sc); }
            float v1 = -3.0e38f, v2 = -3.0e38f; int i1 = 0, i2 = 0;
#pragma unroll
            for (int e = 0; e < 8; ++e) { const float l = acc[e] * rs; if (l > v1) { v2 = v1; i2 = i1; v1 = l; i1 = e; } else if (l > v2) { v2 = l; i2 = e; } }
            if (lane == 0) {
                const float ex = __expf(v2 - v1), w1 = 1.0f / (1.0f + ex), w2 = ex * w1;
                tok_w[t] = w1; tok_w[M + t] = w2; tok_rs[t] = rs;
                le[ti] = i1; le[128 + ti] = i2;
                lp[ti] = __hip_atomic_fetch_add(lcnt + i1, 1, __ATOMIC_RELAXED, __HIP_MEMORY_SCOPE_WORKGROUP);
                lp[128 + ti] = __hip_atomic_fetch_add(lcnt + 8 + i2, 1, __ATOMIC_RELAXED, __HIP_MEMORY_SCOPE_WORKGROUP);
            }
        }
        WG_BAR();
        if (tid < 16) { lbase[tid] = (int)__hip_atomic_fetch_add(gcnt + 64 * tid, (unsigned)lcnt[tid], __ATOMIC_RELAXED, __HIP_MEMORY_SCOPE_AGENT); lcnt[tid] = 0; }
        WG_BAR();
        if (tid < 256) { const int k = tid >> 7, ti = tid & 127, e = le[k * 128 + ti]; tok_e[k * M + t0 + ti] = e; tok_p[k * M + t0 + ti] = lbase[8 * k + e] + lp[k * 128 + ti]; }
        WG_BAR();
    }
}
__device__ __forceinline__ void moe_offsets(const Args& a, volatile LAS int* off, volatile LAS int* npan, int tid) {
    if (tid == 0) { const unsigned* gcnt = (const unsigned*)(a.ws + WS_CTL) + CW_CNT; int o = 0;
        for (int e = 0; e < 8; ++e) { const int n0 = (int)__hip_atomic_load(gcnt + 64 * e, __ATOMIC_RELAXED, __HIP_MEMORY_SCOPE_AGENT), n1 = (int)__hip_atomic_load(gcnt + 64 * (8 + e), __ATOMIC_RELAXED, __HIP_MEMORY_SCOPE_AGENT);
            off[16 + e] = o; off[e] = o; off[8 + e] = o + n0; o += ((n0 + n1 + 255) >> 8) << 8; }
        npan[0] = 0; npan[1] = o >> 8; }
    WG_BAR();
}
__device__ __forceinline__ void assign_phase(const Args& a, volatile LAS int* off, volatile LAS int* npan, int vcu, int G, int tid) {
    unsigned char* ws = a.ws; const int lane = tid & 63, wave = tid >> 6;
    moe_offsets(a, off, npan, tid);
    if (blockIdx.x == 0 && tid < 320) { const int p = tid; int* pe = (int*)(ws + WS_PANE);
        if (p < npan[1]) { int j = 0; for (int q = 1; q < 8; ++q) if (p * 256 >= off[16 + q]) j = q; pe[p] = j; }
        if (p == 0) ((int*)(ws + WS_NPAN))[0] = npan[1]; }
    const int* tok_e = (const int*)(ws + WS_TOKE); const int* tok_p = (const int*)(ws + WS_TOKP); const float* tok_w = (const float*)(ws + WS_TOKW);
    int* row_tok = (int*)(ws + WS_ROWTOK); float* row_w = (float*)(ws + WS_ROWW);
    const unsigned char* xb8 = ws + WS_R + R_H; unsigned char* AS = ws + WS_R + R_AS;
    const int gw = vcu * NWAVES + wave, NGW = G * NWAVES;
    for (int t = gw; t < M; t += NGW) {
        const v4u* src = (const v4u*)(xb8 + (size_t)t * D) + lane; const v4u q0 = src[0], q1 = src[64];
#pragma unroll
        for (int k = 0; k < 2; ++k) { const int e = tok_e[k * M + t], p = off[8 * k + e] + tok_p[k * M + t];
            if (lane == 0) { __hip_atomic_store(row_tok + p, k * M + t, __ATOMIC_RELAXED, __HIP_MEMORY_SCOPE_AGENT); __hip_atomic_store(row_w + p, tok_w[k * M + t], __ATOMIC_RELAXED, __HIP_MEMORY_SCOPE_AGENT); }
            v4u* dst = (v4u*)(AS + (size_t)p * D) + lane; dst[0] = q0; dst[64] = q1; }
    }
}

__device__ __forceinline__ Args ldargs() {
#if defined(__HIP_DEVICE_COMPILE__)
    const __attribute__((address_space(4))) unsigned char* p = (const __attribute__((address_space(4))) unsigned char*)__builtin_amdgcn_kernarg_segment_ptr(); asm volatile("" : "+s"(p));
    Args a; __builtin_memcpy(&a, (const unsigned char*)p, sizeof(Args)); return a;
#else
    return Args{};
#endif
}
__global__ void __launch_bounds__(NWAVES * 64, 2) trunk_fwd(Args kargs) {
    extern __shared__ __attribute__((aligned(16))) unsigned char lds_raw[];
    LAS unsigned char* lds = (LAS unsigned char*)lds_raw;
    volatile LAS unsigned* MISC = (volatile LAS unsigned*)(lds + MISC_OFF);
    const int wave = __builtin_amdgcn_readfirstlane((int)threadIdx.x >> 6);
#define LANE() ((int)__builtin_amdgcn_mbcnt_hi(~0u, __builtin_amdgcn_mbcnt_lo(~0u, 0u)))
#define TIDX() (wave * 64 + LANE())
    const int G = gridDim.x; const int bx = blockIdx.x; const int vcu = (G % 8 == 0) ? (bx % 8) * (G / 8) + bx / 8 : bx;
    unsigned char* ws = kargs.ws;
    unsigned* ctl = (unsigned*)(ws + WS_CTL);
    if (threadIdx.x < 64) MISC[threadIdx.x] = 0u;
    __syncthreads();
    XcdBarrier bar; bar.bar = ctl + CW_BAR; bar.x = 0; bar.st = nullptr;
#if !MK_PER_PHASE
    bar = xcd_barrier_post(ctl + CW_BAR, MISC + 8);
#define GRID_BAR() xcd_barrier(bar)
#else
#define GRID_BAR() do { } while (0)
#endif
    const int lo = kargs.ph_lo, hi = kargs.ph_hi;
#ifndef PH_MASK
#define PH_MASK 0xFFFF
#endif
#define IN(k) ((((PH_MASK) >> (k)) & 1) && lo <= (k) && (k) < hi)
#define BOTH(k) (IN(k) && IN((k) + 1))
    using namespace pg8;
    bf16* xb = (bf16*)(ws + WS_XB);
    float* out = kargs.out;

#ifndef PROBE
#define PROBE 0
#endif
#define REPS(k) _Pragma("nounroll") for (int rep = ((PROBE >> (k)) & 1) ? 0 : 1; rep < 2; ++rep)
    if (IN(0)) { const Args args = ldargs(); REPS(0) { p0_prologue(args, lds, vcu, G, wave, LANE()); if (BOTH(0)) GRID_BAR(); } }

    if (IN(1)) {
        Gemm g{(const bf16*)(ws + WS_R + 128 * MiB), (const bf16*)(ws + WS_W_HIN), M, 8192, 1024, 0}; StaticOrder S; S.init(M, 8192, G, bx);
        EpiHgrnIn E{1.0f / (I8_SA * I8_SW), (const float*)(ws + WS_LB), (bf16*)(ws + WS_R + R_Q), (bf16*)(ws + WS_R + R_G), (bf16*)(ws + WS_R + R_I), (bf16*)(ws + WS_R + R_GT)};
        REPS(1) { gemm_phase<EpiHgrnIn, StaticOrder, true, true, false, true>(lds, g, S, E, wave);
        if (BOTH(1)) GRID_BAR(); }
    }
    if (IN(2)) {
        const Args args = ldargs();
        REPS(2) { for (int bh = bx; bh < BATCH * NH; bh += G)
            hgrn_scan_unit(lds, bh, (const bf16*)(ws + WS_R + R_Q), (const bf16*)(ws + WS_R + R_K), (const bf16*)(ws + WS_R + R_G), (const bf16*)(ws + WS_R + R_I), (const bf16*)(ws + WS_R + R_GT), (bf16*)(ws + WS_O), args.in[4], TIDX());
        if (BOTH(2)) GRID_BAR(); }
    }
    if (IN(3)) {
        const Args args = ldargs();
        Gemm g{(const bf16*)(ws + WS_O), (const bf16*)(ws + WS_W_HOUT), M, 2048, 2048, 0}; StaticOrder S; S.init(M, 2048, G, bx);
        REPS(3) { EpiResid<false, false> E{args.in[0], nullptr, nullptr, rep ? xb : (bf16*)(ws + WS_R + 384 * MiB), (u64*)(rep ? ws + WS_RSS1 : ws + WS_R + 512 * MiB), ws + WS_R + 640 * MiB, I8_SA_X1};
        gemm_phase<EpiResid<false, false>, StaticOrder, true, true>(lds, g, S, E, wave);
        if (BOTH(3)) GRID_BAR(); }
    }
    if (IN(4)) {
        Gemm g{(const bf16*)(ws + WS_R + 640 * MiB), (const bf16*)(ws + WS_W_FGU), M, 2 * DFF, 1024, 0}; StaticOrder S; S.init(M, 2 * DFF, G, bx);
        EpiSwigluI<true, false> E{(void*)(ws + WS_R + R_HFF), DFF, 1.0f / (I8_SA_X1 * I8_SW), 1.f, (const u64*)(ws + WS_RSS1)};
        REPS(4) { gemm_phase<EpiSwigluI<true, false>, StaticOrder, true, true, false, true>(lds, g, S, E, wave);
        if (BOTH(4)) GRID_BAR(); }
    }
    if (IN(5)) {
        Gemm g{(const bf16*)(ws + WS_R + R_HFF), (const bf16*)(ws + WS_W_FD), M, 2048, DFF, 0}; StaticOrder S; S.init(M, 2048, G, bx);
        REPS(5) { EpiResidB16 E{xb, rep ? xb : (bf16*)(ws + WS_R + 608 * MiB), (u64*)(rep ? ws + WS_RSS2 : ws + WS_R + 736 * MiB), ws + WS_R + 640 * MiB, I8_SA_X2};
        gemm_phase<EpiResidB16, StaticOrder, true, true>(lds, g, S, E, wave);
        if (BOTH(5)) GRID_BAR(); }
    }
    if (IN(6)) {
        Gemm g{(const bf16*)(ws + WS_R + 640 * MiB), (const bf16*)(ws + WS_W_SIN), M, 4096, 1024, 0}; StaticOrder S; S.init(M, 4096, G, bx);
        REPS(6) { EpiSguIn E{(const u64*)(ws + WS_RSS2), (bf16*)(ws + WS_R + (rep ? R_U : 256 * MiB)), (bf16*)(ws + WS_R + (rep ? R_V : 384 * MiB)), (u64*)(rep ? ws + WS_LNST : ws + WS_R + 512 * MiB), 1.0f / (I8_SA_X2 * I8_SW)};
        gemm_phase<EpiSguIn, StaticOrder, true, true, false, true>(lds, g, S, E, wave);
        if (BOTH(6)) GRID_BAR(); }
    }
    if (IN(7)) {
        const Args args = ldargs();
        int last_g = -1; const int tid = TIDX();
        REPS(7) { SguPre cur, nxt; const int NU = (M / 128) * 16; pg8::f32x2 gg = {0.f, 0.f}, bb = {0.f, 0.f}; float bias0 = 0.f, bias1 = 0.f;
            if (bx < NU) sgu_load((const bf16*)(ws + WS_R + R_V), (const u64*)(ws + WS_LNST), bx >> 4, bx & 15, tid, cur);
            for (int u = bx; u < NU; u += G) { const int g = u & 15, bn = u >> 4;
            if (g != last_g) { sgu_load_wm(lds, args.in[14] + (size_t)g * 128 * 128, tid); last_g = g;
                gg = *(const pg8::f32x2*)(args.in[12] + 128 * g + 2 * (tid & 63)); bb = *(const pg8::f32x2*)(args.in[13] + 128 * g + 2 * (tid & 63));
                bias0 = args.in[15][g * 128 + 32 * (2 * ((tid >> 6) & 1)) + (tid & 31)]; bias1 = args.in[15][g * 128 + 32 * (2 * ((tid >> 6) & 1) + 1) + (tid & 31)]; }
            const int un = (u + G < NU) ? u + G : u;
            sgu_unit(lds, bn, g, (const bf16*)(ws + WS_R + R_U), (bf16*)(ws + WS_R + (rep ? R_U : 256 * MiB)), cur, (const bf16*)(ws + WS_R + R_V), (const u64*)(ws + WS_LNST), un >> 4, un & 15, nxt, gg, bb, bias0, bias1, tid);
            cur = nxt; }
        if (BOTH(7)) GRID_BAR(); }
    }
    if (IN(8)) {
        Gemm g{(const bf16*)(ws + WS_R + R_U), (const bf16*)(ws + WS_W_SOUT), M, 2048, 2048, 0}; StaticOrder S; S.init(M, 2048, G, bx);
        EpiResidB16 E{xb, xb, nullptr, nullptr, 0.f};
        REPS(8) { gemm_phase<EpiResidB16, StaticOrder, true, true>(lds, g, S, E, wave);
        if (BOTH(8)) GRID_BAR(); }
    }
    if (IN(9)) { const Args args = ldargs(); router_phase(args, lds, G, TIDX()); if (BOTH(9)) GRID_BAR(); }
    if (IN(10)) { const Args args = ldargs(); REPS(10) { assign_phase(args, (volatile LAS int*)(MISC + 16), (volatile LAS int*)(MISC + 48), vcu, G, TIDX()); if (BOTH(10)) GRID_BAR(); } }
    if (IN(11)) {
        const int np = __builtin_amdgcn_readfirstlane(((const int*)(ws + WS_NPAN))[0]);
        Gemm g{(const bf16*)(ws + WS_R + R_AS), (const bf16*)(ws + WS_W_MGU), np * 256, 2 * DFFE, 1024, (size_t)2 * DFFE * 2048};
        MoeOrder S; S.init(np, 2 * DFFE / 256, G, bx, (const int*)(ws + WS_PANE));
        EpiSwiglu8 E{ws + WS_R + R_H, DFFE, 1.0f / (F8_SA * F8_SW_UP), F8_SH};
        REPS(11) { gemm_phase<EpiSwiglu8, MoeOrder, true, true, true>(lds, g, S, E, wave);
        if (BOTH(11)) GRID_BAR(); }
    }
    if (IN(12)) {
        const int np = __builtin_amdgcn_readfirstlane(((const int*)(ws + WS_NPAN))[0]);
        Gemm g{(const bf16*)(ws + WS_R + R_H), (const bf16*)(ws + WS_W_MD), np * 256, 2048, DFFE / 2, (size_t)2048 * DFFE};
        MoeOrder S; S.init(np, 8, G, bx, (const int*)(ws + WS_PANE));
        EpiY E{(bf16*)(ws + WS_R + R_Y), (const int*)(ws + WS_ROWTOK), (const float*)(ws + WS_ROWW), 1.0f / (F8_SH * F8_SW_DN)};
        REPS(12) { gemm_phase<EpiY, MoeOrder, true, F8SP2, true>(lds, g, S, E, wave);
        if (BOTH(12) || (IN(12) && IN(15))) GRID_BAR(); }
    }
    if (IN(15)) {
        const Args args = ldargs();
        const float* fg = args.in[22]; const int gw = vcu * NWAVES + wave, NGW = G * NWAVES, lane = LANE();
        f32x4 gv[8];
#pragma unroll
        for (int j = 0; j < 4; ++j) { gv[2 * j] = ((const f32x4*)fg)[2 * lane + 128 * j]; gv[2 * j + 1] = ((const f32x4*)fg)[2 * lane + 1 + 128 * j]; }
        REPS(15) { float* dsto = rep ? out : (float*)(ws + WS_R + 272 * MiB);
        for (int m = gw; m < M; m += NGW) {
            const v4u* xr = (const v4u*)(xb + (size_t)m * D) + lane; f32x4* xw = (f32x4*)(dsto + (size_t)m * D) + 2 * lane; f32x4 v[8]; float s = 0.f;
            const v4u* y0 = (const v4u*)((const bf16*)(ws + WS_R + R_Y) + (size_t)m * D) + lane; const v4u* y1 = (const v4u*)((const bf16*)(ws + WS_R + R_Y) + (size_t)(M + m) * D) + lane;
#pragma unroll
            for (int j = 0; j < 4; ++j) { const v4u a0 = y0[64 * j], a1 = y1[64 * j], xq = xr[64 * j];
                v[2 * j] = (f32x4){bflo(xq.x) + (bflo(a0.x) + bflo(a1.x)), bfhi(xq.x) + (bfhi(a0.x) + bfhi(a1.x)), bflo(xq.y) + (bflo(a0.y) + bflo(a1.y)), bfhi(xq.y) + (bfhi(a0.y) + bfhi(a1.y))};
                v[2 * j + 1] = (f32x4){bflo(xq.z) + (bflo(a0.z) + bflo(a1.z)), bfhi(xq.z) + (bfhi(a0.z) + bfhi(a1.z)), bflo(xq.w) + (bflo(a0.w) + bflo(a1.w)), bfhi(xq.w) + (bfhi(a0.w) + bfhi(a1.w))};
                s += ((v[2 * j].x * v[2 * j].x + v[2 * j].y * v[2 * j].y) + (v[2 * j].z * v[2 * j].z + v[2 * j].w * v[2 * j].w)) + ((v[2 * j + 1].x * v[2 * j + 1].x + v[2 * j + 1].y * v[2 * j + 1].y) + (v[2 * j + 1].z * v[2 * j + 1].z + v[2 * j + 1].w * v[2 * j + 1].w)); }
            const float rs = 1.0f / sqrtf(wave_sum(s) * (1.0f / 2048.0f) + EPS);
#pragma unroll
            for (int j = 0; j < 4; ++j) { xw[128 * j] = v[2 * j] * rs * gv[2 * j]; xw[128 * j + 1] = v[2 * j + 1] * rs * gv[2 * j + 1]; }
        }
        if (rep == 0) GRID_BAR(); }
    }
#undef IN
#undef BOTH
}

extern "C" void kernel_launch(void* const* d_in, const int* in_sizes, int n_in, void* d_out, int out_size, void* d_ws, size_t ws_size, hipStream_t stream) {
    static int grid = 0;
    if (grid == 0) {
        if (n_in != 23 || in_sizes[0] != M * D || out_size != M * D || ws_size < WS_END) { fprintf(stderr, "kernel_launch: shape/workspace mismatch (n_in %d, in0 %d, out %d, ws %zu, need %zu)\n", n_in, n_in > 0 ? in_sizes[0] : -1, out_size, ws_size, (size_t)WS_END); grid = -1; return; }
        int dev = 0, cus = 0, per_cu = 0;
        if (hipGetDevice(&dev) != hipSuccess || hipDeviceGetAttribute(&cus, hipDeviceAttributeMultiprocessorCount, dev) != hipSuccess) { grid = -1; return; }
        if (hipFuncSetAttribute((const void*)trunk_fwd, hipFuncAttributeMaxDynamicSharedMemorySize, LDS_BYTES) != hipSuccess) { fprintf(stderr, "kernel_launch: hipFuncSetAttribute failed\n"); grid = -1; return; }
        if (hipOccupancyMaxActiveBlocksPerMultiprocessor(&per_cu, (const void*)trunk_fwd, NWAVES * 64, LDS_BYTES) != hipSuccess || per_cu < 1) fprintf(stderr, "kernel_launch: occupancy query reports %d\n", per_cu);
        (void)hipGetLastError();
        grid = cus;
    }
    if (grid < 0) return;
    if (hipMemsetAsync((char*)d_ws + WS_CTL, 0, CTL_ZERO_BYTES, stream) != hipSuccess) return;
    Args a{};
    for (int i = 0; i < 23; ++i) a.in[i] = (const float*)d_in[i];
    a.out = (float*)d_out; a.ws = (unsigned char*)d_ws;
#if MK_PER_PHASE
    for (int p = 0; p < NPH; ++p) { a.ph_lo = p; a.ph_hi = p + 1; hipLaunchKernelGGL(trunk_fwd, dim3(grid), dim3(NWAVES * 64), LDS_BYTES, stream, a); }
#else
    a.ph_lo = 0; a.ph_hi = NPH;
    hipLaunchKernelGGL(trunk_fwd, dim3(grid), dim3(NWAVES * 64), LDS_BYTES, stream, a);
#endif
}
```

```cpp
#include <hip/hip_runtime.h>
#include <cstdio>
#include <cstdint>

#ifndef MK_PER_PHASE
#define MK_PER_PHASE 0
#endif

#ifndef KF_DEFAULT
#define KF_DEFAULT false
#endif
#ifndef KF_SWIGLU
#define KF_SWIGLU true
#endif
#ifndef KF_SGU
#define KF_SGU true
#endif
#ifndef ASM_STAGE
#define ASM_STAGE true
#endif
namespace pg8 {
#define PG8_LAS __attribute__((address_space(3)))
typedef unsigned short bf16_t;
typedef short bf16x8 __attribute__((ext_vector_type(8)));
typedef float f32x4 __attribute__((ext_vector_type(4)));
typedef float f32x2 __attribute__((ext_vector_type(2)));
typedef unsigned u32x4 __attribute__((ext_vector_type(4)));
typedef unsigned u32x2 __attribute__((ext_vector_type(2)));
typedef int i32x4 __attribute__((ext_vector_type(4)));
typedef int i32x8 __attribute__((ext_vector_type(8)));
__device__ __forceinline__ i32x8 cat8(bf16x8 a, bf16x8 b) { const i32x4 x = __builtin_bit_cast(i32x4, a), y = __builtin_bit_cast(i32x4, b); return __builtin_shufflevector(x, y, 0, 1, 2, 3, 4, 5, 6, 7); }
template <int OFF> __device__ __forceinline__ void glds16_s(const void* sbase, unsigned voff, unsigned lds_w) {
    const unsigned long long gb = (unsigned long long)sbase;
    const unsigned lo = __builtin_amdgcn_readfirstlane((unsigned)gb), hi = __builtin_amdgcn_readfirstlane((unsigned)(gb >> 32));
    const unsigned long long sb = ((unsigned long long)hi << 32) | lo; unsigned keep;
    asm volatile("s_mov_b32 %0, m0\n\ts_add_i32 m0, %3, %4\n\ts_nop 0\n\tglobal_load_lds_dwordx4 %1, %2\n\ts_mov_b32 m0, %0" : "=&s"(keep) : "v"(voff), "s"(sb), "s"(lds_w), "i"(OFF) : "memory", "scc");
}
__device__ __forceinline__ unsigned pk4_fp8(float a, float b, float c, float d) {
    a = __builtin_amdgcn_fmed3f(a, -448.f, 448.f); b = __builtin_amdgcn_fmed3f(b, -448.f, 448.f); c = __builtin_amdgcn_fmed3f(c, -448.f, 448.f); d = __builtin_amdgcn_fmed3f(d, -448.f, 448.f);
    int w = __builtin_amdgcn_cvt_pk_fp8_f32(a, b, 0, false); w = __builtin_amdgcn_cvt_pk_fp8_f32(c, d, w, true); return (unsigned)w; }
__device__ __forceinline__ unsigned pk4_i8(float a, float b, float c, float d) {
    a = __builtin_amdgcn_fmed3f(a, -127.f, 127.f) + 12582912.0f; b = __builtin_amdgcn_fmed3f(b, -127.f, 127.f) + 12582912.0f; c = __builtin_amdgcn_fmed3f(c, -127.f, 127.f) + 12582912.0f; d = __builtin_amdgcn_fmed3f(d, -127.f, 127.f) + 12582912.0f;
    const unsigned p01 = __builtin_amdgcn_perm(__builtin_bit_cast(unsigned, b), __builtin_bit_cast(unsigned, a), 0x0c0c0400u), p23 = __builtin_amdgcn_perm(__builtin_bit_cast(unsigned, d), __builtin_bit_cast(unsigned, c), 0x0c0c0400u);
    return __builtin_amdgcn_perm(p23, p01, 0x05040100u); }
constexpr int BM = 256, BK = 64, HALF = 128, HTB = HALF * BK * 2  , STAGE_BYTES = 8 * HTB, NXCD = 8, WGM = 8;

__host__ __device__ __forceinline__ int lds_byte(int r, int c) { const int st = (r >> 4) * 2 + (c >> 5), rr = r & 15, cc = c & 31, ob = rr * 64 + cc * 2; return st * 1024 + (ob ^ (((ob >> 9) & 1) << 5)); }
__host__ __device__ __forceinline__ void stage_rc(int b, int& R, int& C) { const int st = b / 1024, sb = b % 1024, swz = sb ^ (((sb >> 9) & 1) << 5); R = (st >> 1) * 16 + swz / 64; C = (st & 1) * 32 + (swz % 64) / 2; }
__host__ __device__ __forceinline__ int perm32(int rho) { const int n = rho >> 4, i = rho & 15; return 8 * (i >> 2) + 4 * n + (i & 3); }

struct Unit { int pm, pn, e; };
struct Gemm { const bf16_t* A; const bf16_t* Bt; int M, N, K; size_t estride; };

struct StaticOrder {
    int nM, nN, nwg, G, c;
    __host__ __device__ void init(int M, int N, int G_, int c_) { nM = M / BM; nN = N / BM; nwg = nM * nN; G = G_; c = c_; }
    __host__ __device__ bool next(int i, Unit& u) const {
        const long L = (long)i * G + c; if (L >= nwg) return false;
        int wgid = (int)L; { const int q = nwg / NXCD, r = nwg % NXCD, xcd = wgid % NXCD, off = wgid / NXCD; wgid = (xcd < r ? xcd * (q + 1) : r * (q + 1) + (xcd - r) * q) + off; }
        const int nig = WGM * nN, gid = wgid / nig, fm = gid * WGM, gsz = (nM - fm) < WGM ? (nM - fm) : WGM;
        u.pm = fm + ((wgid % nig) % gsz); u.pn = (wgid % nig) / gsz; u.e = 0; return true;
    }
    __device__ __forceinline__ void a_ready(const Unit&) const {}
    __device__ __forceinline__ void done(const Unit&) const {}
};
struct ConstOrder {
    int nwg, G, c;
    __device__ void init(int M, int N, int G_, int c_) { nwg = (M / BM) * (N / BM); G = G_; c = c_; }
    __device__ bool next(int i, Unit& u) const { const long L = (long)i * G + c; if (L >= nwg) return false; u.pm = 0; u.pn = 0; u.e = 0; return true; }
    __device__ __forceinline__ void a_ready(const Unit&) const {}
    __device__ __forceinline__ void done(const Unit&) const {}
};
struct MoeOrder {
    int nM, nN, nwg, G, c; const int* panel_e;
    __device__ void init(int nM_, int nN_, int G_, int c_, const int* pe) { nM = nM_; nN = nN_; nwg = nM * nN; G = G_; c = c_; panel_e = pe; }
    __device__ bool next(int i, Unit& u) const {
        const long L = (long)i * G + c; if (L >= nwg) return false;
        int wgid = (int)L; { const int q = nwg / NXCD, r = nwg % NXCD, xcd = wgid % NXCD, off = wgid / NXCD; wgid = (xcd < r ? xcd * (q + 1) : r * (q + 1) + (xcd - r) * q) + off; }
        const int nig = WGM * nN, gid = wgid / nig, fm = gid * WGM, gsz = (nM - fm) < WGM ? (nM - fm) : WGM;
        u.pm = fm + ((wgid % nig) % gsz); u.pn = (wgid % nig) / gsz; u.e = __builtin_amdgcn_readfirstlane(panel_e[u.pm]); return true;
    }
    __device__ __forceinline__ void a_ready(const Unit&) const {}
    __device__ __forceinline__ void done(const Unit&) const {}
};

__device__ __forceinline__ unsigned cvt_pk_bf16(float lo, float hi) { unsigned r; asm volatile("v_cvt_pk_bf16_f32 %0, %1, %2" : "=v"(r) : "v"(lo), "v"(hi)); return r; }
__device__ __forceinline__ f32x2 gelu_pk(f32x2 v) {
    const f32x2 av = __builtin_elementwise_abs(v), d = av * 0.2316418882f + 1.0f;
    f32x2 t; t.x = __builtin_amdgcn_rcpf(d.x); t.y = __builtin_amdgcn_rcpf(d.y);
    f32x2 q = t * 0.5307027145f + (-0.7265760135f); q = q * t + 0.7107068705f; q = q * t + (-0.142248368f); q = q * t + 0.127414796f; q = q * t;
    const f32x2 s = (v * v) * (-0.72134752044f);
    f32x2 e; e.x = __builtin_amdgcn_exp2f(s.x); e.y = __builtin_amdgcn_exp2f(s.y);
    const f32x2 m = av * (q * e);
    f32x2 o; o.x = fmaxf(v.x, 0.f) - m.x; o.y = fmaxf(v.y, 0.f) - m.y; return o;
}
__device__ __forceinline__ float fsilu(float x) { return x * __builtin_amdgcn_rcpf(1.f + __builtin_amdgcn_exp2f(-1.44269504f * x)); }
constexpr float INV_D = 1.0f / 2048.0f, RMS_EPS = 1e-6f;
constexpr float FX_SCALE = 16777216.0f, FX_INV = 1.0f / 16777216.0f;
typedef unsigned long long u64;
__device__ __forceinline__ void fx_add(u64* p, float v) { atomicAdd(p, (u64)(long long)__float2ll_rn(v * FX_SCALE)); }
__device__ __forceinline__ float fx_get(const u64* p) { return (float)(long long)(*p) * FX_INV; }
constexpr int RSL_OFF = 131072;
__device__ __forceinline__ void rs_prefetch(const u64* rss, int pm, PG8_LAS unsigned char* lds, int wid, int slot) {
    const int lane = (int)__builtin_amdgcn_mbcnt_hi(~0u, __builtin_amdgcn_mbcnt_lo(~0u, 0u));
    const unsigned dst = __builtin_amdgcn_readfirstlane((unsigned)(size_t)lds + (unsigned)(RSL_OFF + slot * 2048 + (wid & 1) * 1024));
    glds16_s<0>((const void*)(rss + (size_t)pm * 256), (unsigned)((wid & 1) * 1024 + lane * 16), dst);
}
__device__ __forceinline__ float fx_get_lds(const PG8_LAS u64* p) { return (float)(long long)(*p) * FX_INV; }
__device__ __forceinline__ float fx_rs_lds(const PG8_LAS u64* p, float sc) { const u64 v = *p;
    const float m = __builtin_fmaf((float)(unsigned)(v >> 32), 4294967296.0f * FX_INV * INV_D, __builtin_fmaf((float)(unsigned)v, FX_INV * INV_D, RMS_EPS)); return sc * __builtin_amdgcn_rsqf(m); }

struct EpiHgrnIn {
    static constexpr bool PERM = true, AFTER_DRAIN = false, RSP = false, KEEPF = KF_DEFAULT;
    float sc; const float* lb; bf16_t *Q, *Gl, *Iv, *Gt;
    __device__ __forceinline__ void operator()(const f32x4 (&acc)[2][2][4][2], const Unit& u, int wr, int wc, int fr, int fq) const {
        const int seg = u.pn >> 3, row0 = u.pm * BM + wr * 64 + fr, col0 = (u.pn & 7) * BM + wc * 32 + 8 * fq;
        const float k1 = -1.44269504f * sc, isc = 1.0f / sc, fcl = 30.f / sc;
        auto isilu = [k1, isc](float t) { return t * __builtin_amdgcn_rcpf(__builtin_fmaf(__builtin_amdgcn_exp2f(t * k1), isc, isc)); };
        float lv[2][8];
        if (seg == 1) {
#pragma unroll
            for (int bj = 0; bj < 2; ++bj) { const f32x4 l0 = *(const f32x4*)(lb + col0 + bj * HALF), l1 = *(const f32x4*)(lb + col0 + bj * HALF + 4);
                lv[bj][0] = l0[0]; lv[bj][1] = l0[1]; lv[bj][2] = l0[2]; lv[bj][3] = l0[3]; lv[bj][4] = l1[0]; lv[bj][5] = l1[1]; lv[bj][6] = l1[2]; lv[bj][7] = l1[3];
#pragma unroll
                for (int j = 0; j < 8; ++j) asm volatile("" : "+v"(lv[bj][j])); } }
#pragma unroll
        for (int ai = 0; ai < 2; ++ai)
#pragma unroll
            for (int m = 0; m < 4; ++m) {
                const int r = row0 + ai * HALF + m * 16; const size_t off = (size_t)r * 2048 + col0;
#pragma unroll
                for (int bj = 0; bj < 2; ++bj) {
                    const i32x4 i0 = __builtin_bit_cast(i32x4, acc[ai][bj][m][0]), i1 = __builtin_bit_cast(i32x4, acc[ai][bj][m][1]);
                    const float v[8] = {(float)i0[0], (float)i0[1], (float)i0[2], (float)i0[3], (float)i1[0], (float)i1[1], (float)i1[2], (float)i1[3]};
                    if (seg == 0) { u32x4 w; w.x = cvt_pk_bf16(isilu(v[0]), isilu(v[1])); w.y = cvt_pk_bf16(isilu(v[2]), isilu(v[3])); w.z = cvt_pk_bf16(isilu(v[4]), isilu(v[5])); w.w = cvt_pk_bf16(isilu(v[6]), isilu(v[7])); *(u32x4*)(Q + off + bj * HALF) = w; }
                    else if (seg == 1) {
                        float gl[8];
#pragma unroll
                        for (int j = 0; j < 8; ++j) { const float f = __builtin_amdgcn_fmed3f(v[j], -fcl, fcl), e = __builtin_amdgcn_exp2f(k1 * f), sg = __builtin_amdgcn_rcpf(1.f + e), om = 1.f - lv[bj][j];
                            gl[j] = __logf(lv[bj][j] + om * sg); }
                        u32x4 w; w.x = cvt_pk_bf16(gl[0], gl[1]); w.y = cvt_pk_bf16(gl[2], gl[3]); w.z = cvt_pk_bf16(gl[4], gl[5]); w.w = cvt_pk_bf16(gl[6], gl[7]); *(u32x4*)(Gl + off + bj * HALF) = w; }
                    else if (seg == 2) { u32x4 w; w.x = cvt_pk_bf16(v[0] * sc, v[1] * sc); w.y = cvt_pk_bf16(v[2] * sc, v[3] * sc); w.z = cvt_pk_bf16(v[4] * sc, v[5] * sc); w.w = cvt_pk_bf16(v[6] * sc, v[7] * sc); *(u32x4*)(Iv + off + bj * HALF) = w; }
                    else { u32x4 w; w.x = cvt_pk_bf16(isilu(v[0]), isilu(v[1])); w.y = cvt_pk_bf16(isilu(v[2]), isilu(v[3])); w.z = cvt_pk_bf16(isilu(v[4]), isilu(v[5])); w.w = cvt_pk_bf16(isilu(v[6]), isilu(v[7])); *(u32x4*)(Gt + off + bj * HALF) = w; }
                } }
    }
};

template <bool RB16, bool WF32> struct EpiResid {
    static constexpr bool PERM = false, AFTER_DRAIN = false, RSP = false, KEEPF = KF_DEFAULT;
    const float* resid; const bf16_t* rb16; float* out; bf16_t* xb; u64* rowss; unsigned char* x8; float sc8;
    __device__ __forceinline__ void operator()(const f32x4 (&acc)[2][2][4][2], const Unit& u, int wr, int wc, int fr, int fq) const {
        const int row0 = u.pm * BM + wr * 64 + fr, col0 = u.pn * BM + wc * 32 + 4 * fq;
#pragma unroll
        for (int ai = 0; ai < 2; ++ai) {
            f32x4 rv[4][4];
#pragma unroll
            for (int m = 0; m < 4; ++m) { const size_t off = (size_t)(row0 + ai * HALF + m * 16) * 2048 + col0;
#pragma unroll
                for (int q = 0; q < 4; ++q) { const int c = (q >> 1) * HALF + (q & 1) * 16;
                    if (RB16) { const u32x2 b = *(const u32x2*)(rb16 + off + c); rv[m][q] = (f32x4){__builtin_bit_cast(float, b.x << 16), __builtin_bit_cast(float, b.x & 0xffff0000u), __builtin_bit_cast(float, b.y << 16), __builtin_bit_cast(float, b.y & 0xffff0000u)}; }
                    else rv[m][q] = *(const f32x4*)(resid + off + c); } }
#pragma unroll
            for (int m = 0; m < 4; ++m) { const int r = row0 + ai * HALF + m * 16; const size_t off = (size_t)r * 2048 + col0; float ss = 0.f;
#pragma unroll
                for (int q = 0; q < 4; ++q) { const int c = (q >> 1) * HALF + (q & 1) * 16;
                    const f32x4 v = rv[m][q] + acc[ai][q >> 1][m][q & 1]; if (WF32) *(f32x4*)(out + off + c) = v; ss += (v[0] * v[0] + v[1] * v[1]) + (v[2] * v[2] + v[3] * v[3]);
                    if (xb) { u32x2 p; p.x = cvt_pk_bf16(v[0], v[1]); p.y = cvt_pk_bf16(v[2], v[3]); *(u32x2*)(xb + off + c) = p; }
                    if (x8) *(unsigned*)(x8 + off + c) = pk4_i8(v[0] * sc8, v[1] * sc8, v[2] * sc8, v[3] * sc8); }
                if (rowss) { ss += __shfl_xor(ss, 16); ss += __shfl_xor(ss, 32); if (fq == 0) fx_add(rowss + r, ss); } }
            asm volatile("" ::: "memory"); }
    }
};

struct EpiResidB16 {
    static constexpr bool PERM = true, AFTER_DRAIN = false, RSP = false, KEEPF = KF_DEFAULT;
    const bf16_t* rb16; bf16_t* xb; u64* rowss; unsigned char* x8; float sc8;
    __device__ __forceinline__ void operator()(const f32x4 (&acc)[2][2][4][2], const Unit& u, int wr, int wc, int fr, int fq) const {
        const int row0 = u.pm * BM + wr * 64 + fr, col0 = u.pn * BM + wc * 32 + 8 * fq;
#pragma unroll
        for (int ai = 0; ai < 2; ++ai) {
            u32x4 rv[4][2];
#pragma unroll
            for (int m = 0; m < 4; ++m) { const size_t off = (size_t)(row0 + ai * HALF + m * 16) * 2048 + col0;
#pragma unroll
                for (int bj = 0; bj < 2; ++bj) rv[m][bj] = *(const u32x4*)(rb16 + off + bj * HALF); }
#pragma unroll
            for (int m = 0; m < 4; ++m) { const int r = row0 + ai * HALF + m * 16; const size_t off = (size_t)r * 2048 + col0; float ss = 0.f;
#pragma unroll
                for (int bj = 0; bj < 2; ++bj) { const u32x4 b = rv[m][bj]; const f32x4 a0 = acc[ai][bj][m][0], a1 = acc[ai][bj][m][1];
                    const float v0 = __builtin_bit_cast(float, b.x << 16) + a0[0], v1 = __builtin_bit_cast(float, b.x & 0xffff0000u) + a0[1], v2 = __builtin_bit_cast(float, b.y << 16) + a0[2], v3 = __builtin_bit_cast(float, b.y & 0xffff0000u) + a0[3];
                    const float v4 = __builtin_bit_cast(float, b.z << 16) + a1[0], v5 = __builtin_bit_cast(float, b.z & 0xffff0000u) + a1[1], v6 = __builtin_bit_cast(float, b.w << 16) + a1[2], v7 = __builtin_bit_cast(float, b.w & 0xffff0000u) + a1[3];
                    ss += ((v0 * v0 + v1 * v1) + (v2 * v2 + v3 * v3)) + ((v4 * v4 + v5 * v5) + (v6 * v6 + v7 * v7));
                    u32x4 p; p.x = cvt_pk_bf16(v0, v1); p.y = cvt_pk_bf16(v2, v3); p.z = cvt_pk_bf16(v4, v5); p.w = cvt_pk_bf16(v6, v7);
                    *(u32x4*)(xb + off + bj * HALF) = p;
                    if (x8) { u32x2 q; q.x = pk4_i8(v0 * sc8, v1 * sc8, v2 * sc8, v3 * sc8); q.y = pk4_i8(v4 * sc8, v5 * sc8, v6 * sc8, v7 * sc8); *(u32x2*)(x8 + off + bj * HALF) = q; } }
                if (rowss) { ss += __shfl_xor(ss, 16); ss += __shfl_xor(ss, 32); if (fq == 0) fx_add(rowss + r, ss); } }
            asm volatile("" ::: "memory"); }
    }
};

template <bool RSD> struct EpiSwiglu {
    static constexpr bool PERM = true, AFTER_DRAIN = false, RSP = false, KEEPF = KF_DEFAULT;
    const void* rsv; bf16_t* H; int ldh;
    __device__ __forceinline__ void operator()(const f32x4 (&acc)[2][2][4][2], const Unit& u, int wr, int wc, int fr, int fq) const {
        const int row0 = u.pm * BM + wr * 64 + fr, col0 = u.pn * HALF + wc * 32 + 8 * fq;
        float rsa[8];
#pragma unroll
        for (int i = 0; i < 8; ++i) { const int r = row0 + (i >> 2) * HALF + (i & 3) * 16; rsa[i] = RSD ? ((const float*)rsv)[r] : fx_get((const u64*)rsv + r); }
        if (!RSD) {
#pragma unroll
            for (int i = 0; i < 8; ++i) rsa[i] = 1.0f / sqrtf(rsa[i] * INV_D + RMS_EPS); }
#pragma unroll
        for (int ai = 0; ai < 2; ++ai)
#pragma unroll
            for (int m = 0; m < 4; ++m) {
                const int r = row0 + ai * HALF + m * 16; const float rs = rsa[ai * 4 + m];
                const f32x4 g0 = acc[ai][0][m][0] * rs, g1 = acc[ai][0][m][1] * rs, u0 = acc[ai][1][m][0] * rs, u1 = acc[ai][1][m][1] * rs;
                u32x4 w; w.x = cvt_pk_bf16(fsilu(g0[0]) * u0[0], fsilu(g0[1]) * u0[1]); w.y = cvt_pk_bf16(fsilu(g0[2]) * u0[2], fsilu(g0[3]) * u0[3]);
                w.z = cvt_pk_bf16(fsilu(g1[0]) * u1[0], fsilu(g1[1]) * u1[1]); w.w = cvt_pk_bf16(fsilu(g1[2]) * u1[2], fsilu(g1[3]) * u1[3]);
                *(u32x4*)(H + (size_t)r * ldh + col0) = w; }
    }
};

struct EpiSwiglu8 {
    static constexpr bool PERM = true, AFTER_DRAIN = false, RSP = false, KEEPF = false;
    unsigned char* H; int ldh; float sc_in, sc_out;
    __device__ __forceinline__ void operator()(const f32x4 (&acc)[2][2][4][2], const Unit& u, int wr, int wc, int fr, int fq) const {
        const int row0 = u.pm * BM + wr * 64 + fr, col0 = u.pn * HALF + wc * 32 + 8 * fq;
        const float k1 = -1.44269504f * sc_in, k2i = __builtin_amdgcn_rcpf(sc_in * sc_in * sc_out);
#pragma unroll
        for (int ai = 0; ai < 2; ++ai)
#pragma unroll
            for (int m = 0; m < 4; ++m) {
                const int r = row0 + ai * HALF + m * 16;
                const f32x4 g0 = acc[ai][0][m][0], g1 = acc[ai][0][m][1], u0 = acc[ai][1][m][0], u1 = acc[ai][1][m][1];
                float h[8];
#pragma unroll
                for (int j = 0; j < 4; ++j) { h[j] = (g0[j] * u0[j]) * __builtin_amdgcn_rcpf(__builtin_fmaf(__builtin_amdgcn_exp2f(g0[j] * k1), k2i, k2i)); h[4 + j] = (g1[j] * u1[j]) * __builtin_amdgcn_rcpf(__builtin_fmaf(__builtin_amdgcn_exp2f(g1[j] * k1), k2i, k2i)); }
                u32x2 w; w.x = pk4_fp8(h[0], h[1], h[2], h[3]); w.y = pk4_fp8(h[4], h[5], h[6], h[7]);
                *(u32x2*)(H + (size_t)r * ldh + col0) = w; }
    }
};

template <bool ROWRS, bool OUT8> struct EpiSwigluI {
    static constexpr bool PERM = true, AFTER_DRAIN = false, RSP = ROWRS, KEEPF = KF_SWIGLU;
    void* H; int ldh; float sc_in, sc_out; const u64* rss;
    __device__ __forceinline__ void prefetch(const Unit& u, PG8_LAS unsigned char* lds, int wid, int slot) const { rs_prefetch(rss, u.pm, lds, wid, slot); }
    __device__ __forceinline__ void operator()(const f32x4 (&acc)[2][2][4][2], const Unit& u, int wr, int wc, int fr, int fq, const PG8_LAS unsigned char* rsl = nullptr) const {
        const int row0 = u.pm * BM + wr * 64 + fr, col0 = u.pn * HALF + wc * 32 + 8 * fq;
        float rsa[8];
        if (ROWRS) {
#pragma unroll
            for (int i = 0; i < 8; ++i) rsa[i] = fx_rs_lds((const PG8_LAS u64*)rsl + wr * 64 + fr + (i >> 2) * HALF + (i & 3) * 16, sc_in); }
#pragma unroll
        for (int ai = 0; ai < 2; ++ai)
#pragma unroll
            for (int m = 0; m < 4; ++m) {
                const int r = row0 + ai * HALF + m * 16; const float s = ROWRS ? rsa[ai * 4 + m] : sc_in, k1 = -1.44269504f * s, k2i = __builtin_amdgcn_rcpf(OUT8 ? s * s * sc_out : s * s);
                const i32x4 gi0 = __builtin_bit_cast(i32x4, acc[ai][0][m][0]), gi1 = __builtin_bit_cast(i32x4, acc[ai][0][m][1]), ui0 = __builtin_bit_cast(i32x4, acc[ai][1][m][0]), ui1 = __builtin_bit_cast(i32x4, acc[ai][1][m][1]);
                float h[8];
#pragma unroll
                for (int j = 0; j < 4; ++j) { const float g0 = (float)gi0[j], g1 = (float)gi1[j];
                    h[j] = (g0 * (float)ui0[j]) * __builtin_amdgcn_rcpf(__builtin_fmaf(__builtin_amdgcn_exp2f(g0 * k1), k2i, k2i)); h[4 + j] = (g1 * (float)ui1[j]) * __builtin_amdgcn_rcpf(__builtin_fmaf(__builtin_amdgcn_exp2f(g1 * k1), k2i, k2i)); }
                if (OUT8) { u32x2 w; w.x = pk4_fp8(h[0], h[1], h[2], h[3]); w.y = pk4_fp8(h[4], h[5], h[6], h[7]); *(u32x2*)((unsigned char*)H + (size_t)r * ldh + col0) = w; }
                else { u32x4 w; w.x = cvt_pk_bf16(h[0], h[1]); w.y = cvt_pk_bf16(h[2], h[3]); w.z = cvt_pk_bf16(h[4], h[5]); w.w = cvt_pk_bf16(h[6], h[7]); *(u32x4*)((bf16_t*)H + (size_t)r * ldh + col0) = w; } }
    }
};

struct EpiBf16Plain {
    static constexpr bool PERM = true, AFTER_DRAIN = false, RSP = false, KEEPF = KF_DEFAULT;
    bf16_t* O;
    __device__ __forceinline__ void operator()(const f32x4 (&acc)[2][2][4][2], const Unit& u, int wr, int wc, int fr, int fq) const {
        const int row0 = u.pm * BM + wr * 64 + fr, col0 = u.pn * BM + wc * 32 + 8 * fq;
#pragma unroll
        for (int ai = 0; ai < 2; ++ai)
#pragma unroll
            for (int m = 0; m < 4; ++m) { bf16_t* rowp = O + (size_t)(row0 + ai * HALF + m * 16) * 2048 + col0;
#pragma unroll
                for (int bj = 0; bj < 2; ++bj) { const f32x4 v0 = acc[ai][bj][m][0], v1 = acc[ai][bj][m][1];
                    u32x4 p; p.x = cvt_pk_bf16(v0[0], v0[1]); p.y = cvt_pk_bf16(v0[2], v0[3]); p.z = cvt_pk_bf16(v1[0], v1[1]); p.w = cvt_pk_bf16(v1[2], v1[3]);
                    *(u32x4*)(rowp + bj * HALF) = p; } }
    }
};

struct EpiY {
    static constexpr bool PERM = true, AFTER_DRAIN = false, RSP = false, KEEPF = KF_DEFAULT;
    bf16_t* Y; const int* row_tok; const float* row_w; float sc;
    __device__ __forceinline__ void operator()(const f32x4 (&acc)[2][2][4][2], const Unit& u, int wr, int wc, int fr, int fq) const {
        const int row0 = u.pm * BM + wr * 64 + fr, col0 = u.pn * BM + wc * 32 + 8 * fq;
        int orow[8]; float wv[8];
#pragma unroll
        for (int i = 0; i < 8; ++i) { const int r = row0 + (i >> 2) * HALF + (i & 3) * 16; orow[i] = row_tok[r]; wv[i] = row_w[r]; }
#pragma unroll
        for (int i = 0; i < 8; ++i) asm volatile("" : "+v"(orow[i]), "+v"(wv[i]));
#pragma unroll
        for (int ai = 0; ai < 2; ++ai)
#pragma unroll
            for (int m = 0; m < 4; ++m) { const int o = orow[ai * 4 + m]; const float w = wv[ai * 4 + m] * sc;
                if (o >= 0) {
#pragma unroll
                    for (int bj = 0; bj < 2; ++bj) { const f32x4 v0 = acc[ai][bj][m][0] * w, v1 = acc[ai][bj][m][1] * w;
                        u32x4 p; p.x = cvt_pk_bf16(v0[0], v0[1]); p.y = cvt_pk_bf16(v0[2], v0[3]); p.z = cvt_pk_bf16(v1[0], v1[1]); p.w = cvt_pk_bf16(v1[2], v1[3]);
                        *(u32x4*)(Y + (size_t)o * 2048 + col0 + bj * HALF) = p; } } }
    }
};

struct EpiNull {
    static constexpr bool PERM = true, AFTER_DRAIN = false, RSP = false, KEEPF = KF_DEFAULT;
    bf16_t* H; int ldh;
    __device__ __forceinline__ void operator()(const f32x4 (&acc)[2][2][4][2], const Unit& u, int wr, int wc, int fr, int fq) const {
        const int row0 = u.pm * BM + wr * 64 + fr, col0 = u.pn * HALF + wc * 32 + 8 * fq;
#pragma unroll
        for (int ai = 0; ai < 2; ++ai)
#pragma unroll
            for (int m = 0; m < 4; ++m) { const int r = row0 + ai * HALF + m * 16;
                const f32x4 s = (acc[ai][0][m][0] + acc[ai][0][m][1]) + (acc[ai][1][m][0] + acc[ai][1][m][1]);
                u32x4 w; w.x = __builtin_bit_cast(unsigned, s[0]); w.y = __builtin_bit_cast(unsigned, s[1]); w.z = __builtin_bit_cast(unsigned, s[2]); w.w = __builtin_bit_cast(unsigned, s[3]);
                *(u32x4*)(H + (size_t)r * ldh + col0) = w; }
    }
};

struct EpiSguIn {
    static constexpr bool PERM = true, AFTER_DRAIN = false, RSP = true, KEEPF = KF_SGU;
    const u64* rowss; bf16_t *U, *V; u64* stats; float sc_in;
    __device__ __forceinline__ void prefetch(const Unit& u, PG8_LAS unsigned char* lds, int wid, int slot) const { rs_prefetch(rowss, u.pm, lds, wid, slot); }
    __device__ __forceinline__ void operator()(const f32x4 (&acc)[2][2][4][2], const Unit& u, int wr, int wc, int fr, int fq, const PG8_LAS unsigned char* rsl) const {
        const bool isv = u.pn >= 8; const int row0 = u.pm * BM + wr * 64 + fr, col0 = (u.pn & 7) * BM + wc * 32 + 8 * fq; bf16_t* base = isv ? V : U;
        float rsa[8];
#pragma unroll
        for (int i = 0; i < 8; ++i) rsa[i] = fx_rs_lds((const PG8_LAS u64*)rsl + wr * 64 + fr + (i >> 2) * HALF + (i & 3) * 16, sc_in);
#pragma unroll
        for (int ai = 0; ai < 2; ++ai)
#pragma unroll
            for (int m = 0; m < 4; ++m) {
                const int r = row0 + ai * HALF + m * 16; const float rs = rsa[ai * 4 + m]; float s1 = 0.f, s2 = 0.f;
#pragma unroll
                for (int bj = 0; bj < 2; ++bj) {
                    const i32x4 i0 = __builtin_bit_cast(i32x4, acc[ai][bj][m][0]), i1 = __builtin_bit_cast(i32x4, acc[ai][bj][m][1]);
                    const f32x4 v0 = (f32x4){(float)i0[0], (float)i0[1], (float)i0[2], (float)i0[3]} * rs, v1 = (f32x4){(float)i1[0], (float)i1[1], (float)i1[2], (float)i1[3]} * rs;
                    const f32x2 a = gelu_pk((f32x2){v0[0], v0[1]}), b = gelu_pk((f32x2){v0[2], v0[3]}), c = gelu_pk((f32x2){v1[0], v1[1]}), d = gelu_pk((f32x2){v1[2], v1[3]});
                    s1 += (a.x + a.y) + (b.x + b.y) + (c.x + c.y) + (d.x + d.y); s2 += (a.x * a.x + a.y * a.y) + (b.x * b.x + b.y * b.y) + (c.x * c.x + c.y * c.y) + (d.x * d.x + d.y * d.y);
                    u32x4 w; w.x = cvt_pk_bf16(a.x, a.y); w.y = cvt_pk_bf16(b.x, b.y); w.z = cvt_pk_bf16(c.x, c.y); w.w = cvt_pk_bf16(d.x, d.y);
                    *(u32x4*)(base + (size_t)r * 2048 + col0 + bj * HALF) = w; }
                if (isv) { s1 += __shfl_xor(s1, 16); s1 += __shfl_xor(s1, 32); s2 += __shfl_xor(s2, 16); s2 += __shfl_xor(s2, 32);
                    if (fq == 0) { fx_add(stats + 2 * r, s1); fx_add(stats + 2 * r + 1, s2); } } }
    }
};

template <class Epi, class Sched, bool ALIGN_EPI = false, bool SP2 = false, bool F8 = false, bool I8 = false>
__device__ __forceinline__ void gemm_phase(PG8_LAS unsigned char* lds, const Gemm g, const Sched& S, const Epi& E, const int wv  ) {
    int tid_ = wv * 64 + (int)__builtin_amdgcn_mbcnt_hi(~0u, __builtin_amdgcn_mbcnt_lo(~0u, 0u)); asm volatile("" : "+v"(tid_));
    const int tid = tid_, wid = __builtin_amdgcn_readfirstlane(tid >> 6), lane = tid & 63, wr = wid >> 2, wc = wid & 3, fr = lane & 15, fq = lane >> 4;
    const int K = g.K, nt = K / BK;
    unsigned voffA[2], voffB[2];
#pragma unroll
    for (int i = 0; i < 2; ++i) { int R, C; stage_rc(tid * 16 + i * 8192, R, C); const int Rb = Epi::PERM ? ((R & ~31) + perm32(R & 31)) : R;
        voffA[i] = (unsigned)(R * K + C) * 2u; voffB[i] = (unsigned)(Rb * K + C) * 2u; }
    const size_t kstep = (size_t)(BK * 2);
    const size_t hstep = (size_t)HALF * K * 2;
    const size_t tstep = 2 * hstep;
    const unsigned ldsw = (unsigned)wid * 1024u;
    const unsigned lds_w = __builtin_amdgcn_readfirstlane((unsigned)(size_t)lds + ldsw);
    const int aoff = lds_byte(wr * 64 + fr, fq * 8), boff = lds_byte(wc * 32 + fr, fq * 8);
#define PG8_SA(b, h) (((b) * 2 + (h)) * HTB)
#define PG8_SB(b, h) ((4 + (b) * 2 + (h)) * HTB)
#define PG8_STAGE(bufoff, gbase, voff) do { \
        if constexpr (F8 || ASM_STAGE) { glds16_s<(bufoff)>((const void*)(gbase), (voff)[0], lds_w); glds16_s<(bufoff) + 8192>((const void*)(gbase), (voff)[1], lds_w); } \
        else { _Pragma("unroll") for (int _i = 0; _i < 2; ++_i) __builtin_amdgcn_global_load_lds((const unsigned*)((const char*)(gbase) + (voff)[_i]), (PG8_LAS unsigned*)(lds + (bufoff) + ldsw + _i * 8192), 16, 0, 0); } } while (0)
#define PG8_LDA(dst, b, h) do { _Pragma("unroll") for (int m = 0; m < 4; ++m) _Pragma("unroll") for (int k = 0; k < 2; ++k) dst[m][k] = *(const PG8_LAS bf16x8*)(lds + PG8_SA(b, h) + aoff + m * 2048 + k * 1024); } while (0)
#define PG8_LDB(dst, b, h) do { _Pragma("unroll") for (int n = 0; n < 2; ++n) _Pragma("unroll") for (int k = 0; k < 2; ++k) dst[n][k] = *(const PG8_LAS bf16x8*)(lds + PG8_SB(b, h) + boff + n * 2048 + k * 1024); } while (0)
#define PG8_MMA(ai, bj, At, Bt) PG8_MMAX(ai, bj, At, Bt, false)
#define PG8_MMAX(ai, bj, At, Bt, Z) do { __builtin_amdgcn_s_setprio(1); const f32x4 z4_ = (f32x4){0.f, 0.f, 0.f, 0.f}; (void)z4_; \
        if constexpr (F8) { _Pragma("unroll") for (int m = 0; m < 4; ++m) _Pragma("unroll") for (int n = 0; n < 2; ++n) \
            acc[ai][bj][m][n] = __builtin_amdgcn_mfma_scale_f32_16x16x128_f8f6f4(cat8(Bt[n][0], Bt[n][1]), cat8(At[m][0], At[m][1]), (Z) ? z4_ : acc[ai][bj][m][n], 0, 0, 0, 0, 0, 0); } \
        else if constexpr (I8) { _Pragma("unroll") for (int m = 0; m < 4; ++m) _Pragma("unroll") for (int n = 0; n < 2; ++n) _Pragma("unroll") for (int k = 0; k < 2; ++k) \
            acc[ai][bj][m][n] = __builtin_bit_cast(f32x4, __builtin_amdgcn_mfma_i32_16x16x64_i8(__builtin_bit_cast(i32x4, Bt[n][k]), __builtin_bit_cast(i32x4, At[m][k]), __builtin_bit_cast(i32x4, ((Z) && k == 0) ? z4_ : acc[ai][bj][m][n]), 0, 0, 0)); } \
        else { _Pragma("unroll") for (int m = 0; m < 4; ++m) _Pragma("unroll") for (int n = 0; n < 2; ++n) _Pragma("unroll") for (int k = 0; k < 2; ++k) \
            acc[ai][bj][m][n] = __builtin_amdgcn_mfma_f32_16x16x32_bf16(Bt[n][k], At[m][k], ((Z) && k == 0) ? z4_ : acc[ai][bj][m][n], 0, 0, 0); } \
        __builtin_amdgcn_s_setprio(0); } while (0)
#define PG8_WAIT_V(n) asm volatile("s_waitcnt vmcnt(" #n ")" ::: "memory")
#define PG8_WAIT_L(n) asm volatile("s_waitcnt lgkmcnt(" #n ")" ::: "memory")
#define PG8_BAR __builtin_amdgcn_s_barrier()
#define PG8_SCHED __builtin_amdgcn_sched_barrier(0)
    Unit cur, nxt; int ui = 0;
    if (!S.next(0, cur)) return;
    f32x4 acc[2][2][4][2];
#pragma unroll
    for (int a = 0; a < 2; ++a)
#pragma unroll
        for (int b = 0; b < 2; ++b)
#pragma unroll
            for (int m = 0; m < 4; ++m)
#pragma unroll
                for (int n = 0; n < 2; ++n) { if constexpr (!SP2) acc[a][b][m][n] = (f32x4){0.f, 0.f, 0.f, 0.f}; }
    bf16x8 At[4][2], B0[2][2], B1[2][2];
    const char* cA = (const char*)g.A + (size_t)cur.pm * tstep; const char* cB = (const char*)g.Bt + (size_t)cur.e * g.estride + (size_t)cur.pn * tstep;
    S.a_ready(cur);
    if constexpr (Epi::RSP) E.prefetch(cur, lds, wid, 0);
    if constexpr (SP2) {
        PG8_STAGE(PG8_SB(0, 0), cB, voffB); PG8_STAGE(PG8_SB(0, 1), cB + hstep, voffB); PG8_STAGE(PG8_SA(0, 0), cA, voffA); PG8_STAGE(PG8_SA(0, 1), cA + hstep, voffA);
        if (wr == 1) PG8_BAR;
        PG8_WAIT_V(2); PG8_BAR;
        PG8_STAGE(PG8_SB(1, 0), cB + kstep, voffB); PG8_STAGE(PG8_SA(1, 0), cA + kstep, voffA); PG8_STAGE(PG8_SB(1, 1), cB + hstep + kstep, voffB);
        PG8_WAIT_V(6); PG8_BAR;
    } else {
        PG8_STAGE(PG8_SB(0, 0), cB, voffB); PG8_STAGE(PG8_SA(0, 0), cA, voffA); PG8_STAGE(PG8_SB(0, 1), cB + hstep, voffB); PG8_STAGE(PG8_SA(0, 1), cA + hstep, voffA);
        if (wr == 1) PG8_BAR;
        PG8_WAIT_V(4); PG8_BAR;
        PG8_STAGE(PG8_SB(1, 0), cB + kstep, voffB); PG8_STAGE(PG8_SA(1, 0), cA + kstep, voffA); PG8_STAGE(PG8_SB(1, 1), cB + hstep + kstep, voffB);
        PG8_WAIT_V(6); PG8_BAR;
    }
    for (;;) {
        const bool has_next = S.next(ui + 1, nxt);
        const char* nA = has_next ? (const char*)g.A + (size_t)nxt.pm * tstep : cA; const char* nB = has_next ? (const char*)g.Bt + (size_t)nxt.e * g.estride + (size_t)nxt.pn * tstep : cB;
        for (int t = 0; t < nt; t += 2) {
            const bool last = (t == nt - 2);
            const char* a1 = cA + (size_t)(t + 1) * kstep;
            const char* a2 = last ? nA : cA + (size_t)(t + 2) * kstep; const char* b2 = last ? nB : cB + (size_t)(t + 2) * kstep;
            const char* a3 = a2 + kstep; const char* b3 = b2 + kstep;
            if (last && has_next) { S.a_ready(nxt); if constexpr (Epi::RSP) E.prefetch(nxt, lds, wid, (ui + 1) & 1); }
            if constexpr (SP2) {
            PG8_LDB(B0, 0, 0); PG8_LDB(B1, 0, 1); PG8_SCHED; PG8_LDA(At, 0, 0); PG8_STAGE(PG8_SA(1, 1), a1 + hstep, voffA);
            PG8_WAIT_V(8); PG8_WAIT_L(0); PG8_BAR; if (t == 0) { PG8_MMAX(0, 0, At, B0, true); PG8_MMAX(0, 1, At, B1, true); } else { PG8_MMA(0, 0, At, B0); PG8_MMA(0, 1, At, B1); } PG8_BAR; PG8_SCHED;
            PG8_LDA(At, 0, 1); PG8_STAGE(PG8_SB(0, 0), b2, voffB); PG8_STAGE(PG8_SB(0, 1), b2 + hstep, voffB); PG8_STAGE(PG8_SA(0, 0), a2, voffA);
            PG8_WAIT_V(8); PG8_WAIT_L(0); PG8_BAR; if (t == 0) { PG8_MMAX(1, 0, At, B0, true); PG8_MMAX(1, 1, At, B1, true); } else { PG8_MMA(1, 0, At, B0); PG8_MMA(1, 1, At, B1); } PG8_BAR; PG8_SCHED;
            PG8_LDB(B0, 1, 0); PG8_LDB(B1, 1, 1); PG8_SCHED; PG8_LDA(At, 1, 0); PG8_STAGE(PG8_SA(0, 1), a2 + hstep, voffA);
            PG8_WAIT_V(8); PG8_WAIT_L(0); PG8_BAR; PG8_MMA(0, 0, At, B0); PG8_MMA(0, 1, At, B1); PG8_BAR; PG8_SCHED;
            PG8_LDA(At, 1, 1); PG8_STAGE(PG8_SB(1, 0), b3, voffB); PG8_STAGE(PG8_SB(1, 1), b3 + hstep, voffB); PG8_STAGE(PG8_SA(1, 0), a3, voffA);
            PG8_WAIT_V(8); PG8_WAIT_L(0); PG8_BAR; PG8_MMA(1, 0, At, B0); PG8_MMA(1, 1, At, B1); PG8_BAR; PG8_SCHED;
            } else {
            PG8_LDB(B0, 0, 0); PG8_SCHED; PG8_LDA(At, 0, 0); PG8_STAGE(PG8_SA(1, 1), a1 + hstep, voffA);
            PG8_WAIT_L(8); PG8_BAR; PG8_WAIT_L(0); PG8_MMA(0, 0, At, B0); PG8_BAR; PG8_SCHED;
            PG8_LDB(B1, 0, 1); PG8_STAGE(PG8_SB(0, 0), b2, voffB);
            PG8_BAR; PG8_WAIT_L(0); PG8_MMA(0, 1, At, B1); PG8_BAR;
            PG8_LDA(At, 0, 1); PG8_STAGE(PG8_SA(0, 0), a2, voffA);
            PG8_BAR; PG8_WAIT_L(0); PG8_MMA(1, 0, At, B0); PG8_BAR; PG8_SCHED;
            PG8_STAGE(PG8_SB(0, 1), b2 + hstep, voffB);
            PG8_WAIT_V(6); PG8_BAR; PG8_MMA(1, 1, At, B1); PG8_BAR;
            PG8_LDB(B0, 1, 0); PG8_SCHED; PG8_LDA(At, 1, 0); PG8_STAGE(PG8_SA(0, 1), a2 + hstep, voffA);
            PG8_WAIT_L(8); PG8_BAR; PG8_WAIT_L(0); PG8_MMA(0, 0, At, B0); PG8_BAR; PG8_SCHED;
            PG8_LDB(B1, 1, 1); PG8_STAGE(PG8_SB(1, 0), b3, voffB);
            PG8_BAR; PG8_WAIT_L(0); PG8_MMA(0, 1, At, B1); PG8_BAR;
            PG8_LDA(At, 1, 1); PG8_STAGE(PG8_SA(1, 0), a3, voffA);
            PG8_BAR; PG8_WAIT_L(0); PG8_MMA(1, 0, At, B0); PG8_BAR; PG8_SCHED;
            PG8_STAGE(PG8_SB(1, 1), b3 + hstep, voffB);
            PG8_WAIT_V(6); PG8_BAR; PG8_MMA(1, 1, At, B1); PG8_BAR;
            }
        }
        if constexpr (ALIGN_EPI) { if (wr == 0) PG8_BAR; }
        if constexpr (!Epi::AFTER_DRAIN) { { int l2_ = (int)__builtin_amdgcn_mbcnt_hi(~0u, __builtin_amdgcn_mbcnt_lo(~0u, 0u)); asm volatile("" : "+v"(l2_)); if constexpr (Epi::RSP) E(acc, cur, wr, wc, l2_ & 15, l2_ >> 4, (const PG8_LAS unsigned char*)(lds + RSL_OFF + (ui & 1) * 2048)); else E(acc, cur, wr, wc, l2_ & 15, l2_ >> 4); } S.done(cur);     if constexpr (Epi::KEEPF) { _Pragma("unroll") for (int m_ = 0; m_ < 4; ++m_) _Pragma("unroll") for (int k_ = 0; k_ < 2; ++k_) asm volatile("" :: "v"(At[m_][k_])); _Pragma("unroll") for (int n_ = 0; n_ < 2; ++n_) _Pragma("unroll") for (int k_ = 0; k_ < 2; ++k_) asm volatile("" :: "v"(B0[n_][k_]), "v"(B1[n_][k_])); } }
        if (!has_next) break;
#pragma unroll
        for (int a = 0; a < 2; ++a)
#pragma unroll
            for (int b = 0; b < 2; ++b)
#pragma unroll
                for (int m = 0; m < 4; ++m)
#pragma unroll
                    for (int n = 0; n < 2; ++n) { if constexpr (!SP2) acc[a][b][m][n] = (f32x4){0.f, 0.f, 0.f, 0.f}; }
        cur = nxt; cA = nA; cB = nB; ++ui;
        if constexpr (ALIGN_EPI) { if (wr == 1) PG8_BAR; }
    }
    PG8_WAIT_V(0);
    if constexpr (!ALIGN_EPI) { if (wr == 0) PG8_BAR; }
    PG8_BAR;
    if constexpr (Epi::AFTER_DRAIN) { E.fused(acc, cur, wr, wc, fr, fq, lds, wid, lane); S.done(cur); }
#undef PG8_SA
#undef PG8_SB
#undef PG8_STAGE
#undef PG8_LDA
#undef PG8_LDB
#undef PG8_MMA
#undef PG8_WAIT_V
#undef PG8_WAIT_L
#undef PG8_BAR
#undef PG8_SCHED
}
}


constexpr int BATCH = 16, SEQ = 2048, D = 2048, M = BATCH * SEQ;
constexpr int NH = 16, DK = 128, DV = 128, CH = 64, NCH = SEQ / CH;
constexpr int DFF = 5632, NE = 8, DFFE = 7168;
constexpr int SROWS = 34816;
constexpr float EPS = 1e-6f;
constexpr float F8_SA = 16.f, F8_SW_UP = 512.f, F8_SH = 8.f, F8_SW_DN = 1024.f;
constexpr float I8_SA = 31.75f, I8_SA_X1 = 27.f, I8_SA_X2 = 24.f, I8_SW = 1437.f;
constexpr int NPH = 16;
#ifndef F8SP2
#define F8SP2 true
#endif
constexpr int NWAVES = 8;

constexpr size_t MiB = 1u << 20;
constexpr size_t WS_CTL = 0, CTL_ZERO_BYTES = 2 * MiB;
constexpr size_t WS_RSS1 = 1 * MiB, WS_RSS2 = WS_RSS1 + 256 * 1024, WS_LNST = WS_RSS2 + 256 * 1024;
static_assert(WS_LNST + 512 * 1024 <= CTL_ZERO_BYTES, "zeroed region");
constexpr size_t WS_SMALL = 2 * MiB;
constexpr size_t WS_RSS0 = WS_SMALL, WS_LB = WS_RSS0 + 128 * 1024, WS_TOKE = WS_LB + 8192, WS_TOKP = WS_TOKE + 256 * 1024, WS_TOKW = WS_TOKP + 256 * 1024, WS_TOKRS = WS_TOKW + 256 * 1024;
constexpr size_t WS_ROWTOK = WS_TOKRS + 128 * 1024, WS_ROWW = WS_ROWTOK + 2 * SROWS * 4, WS_ROWRS = WS_ROWW + 2 * SROWS * 4, WS_PANE = WS_ROWRS + 2 * SROWS * 4;
constexpr size_t WS_NPAN = WS_PANE + 2 * 160 * 4;
static_assert(WS_NPAN + 64 <= 6 * MiB, "small region");
constexpr size_t WS_W_HIN = 6 * MiB, WS_W_HOUT = WS_W_HIN + 32 * MiB, WS_W_FGU = WS_W_HOUT + 8 * MiB, WS_W_FD = WS_W_FGU + 44 * MiB, WS_W_SIN = WS_W_FD + 22 * MiB, WS_W_SOUT = WS_W_SIN + 16 * MiB;
constexpr size_t WS_W_MGU = WS_W_SOUT + 8 * MiB, WS_W_MD = WS_W_MGU + 448 * MiB, WS_XB = WS_W_MD + 224 * MiB, WS_R = WS_XB + 128 * MiB;
constexpr size_t R_Q = 0, R_K = 128 * MiB, R_G = 256 * MiB, R_I = 384 * MiB, R_GT = 512 * MiB;
constexpr size_t R_HFF = 0;
constexpr size_t R_U = 0, R_V = 128 * MiB;
constexpr size_t R_AS = 0, R_H = 272 * MiB, R_Y = 0;
constexpr size_t WS_YS = WS_R + 748 * MiB;
constexpr size_t WS_O = WS_R + 748 * MiB;
constexpr size_t WS_END = WS_O + 128 * MiB;
static_assert((size_t)SROWS * 2048 * 2 == 136 * MiB && (size_t)SROWS * 7168 * 2 == 476 * MiB, "expert buffers");
constexpr int CW_BAR = 4096;
constexpr int CW_CNT = 8192;

constexpr int LDS_BYTES = 147456;
constexpr int MISC_OFF = LDS_BYTES - 256;

#define GAS __attribute__((address_space(1)))
#define LAS __attribute__((address_space(3)))
typedef unsigned short bf16;
typedef unsigned v4u __attribute__((ext_vector_type(4)));
typedef unsigned v2u __attribute__((ext_vector_type(2)));
typedef float f32x4 __attribute__((ext_vector_type(4)));
typedef float f32x16 __attribute__((ext_vector_type(16)));
typedef short bf16x8 __attribute__((ext_vector_type(8)));
#define LDS_WAIT() asm volatile("s_waitcnt lgkmcnt(0)" ::: "memory")
#define VM_WAIT() asm volatile("s_waitcnt vmcnt(0)" ::: "memory")
#define WG_BAR() do { asm volatile("s_waitcnt lgkmcnt(0)" ::: "memory"); __builtin_amdgcn_s_barrier(); asm volatile("" ::: "memory"); } while (0)
__device__ __forceinline__ unsigned pk2(float lo, float hi) { return pg8::cvt_pk_bf16(lo, hi); }
__device__ __forceinline__ unsigned f2bf(float f) { return pg8::cvt_pk_bf16(f, 0.f) & 0xffffu; }
__device__ __forceinline__ float bf2f(unsigned short b) { return __builtin_bit_cast(float, (unsigned)b << 16); }
__device__ __forceinline__ float bflo(unsigned w) { return __builtin_bit_cast(float, w << 16); }
__device__ __forceinline__ float bfhi(unsigned w) { return __builtin_bit_cast(float, w & 0xffff0000u); }
__device__ __forceinline__ float wave_sum(float v) {
#pragma unroll
    for (int o = 1; o < 64; o <<= 1) v += __shfl_xor(v, o);
    return v;
}

#define XB_TMO      128
#define XB_XCNT(j)  (256  + 64 * (j))
#define XB_XSUB(j)  (1280 + 64 * (j))
#define XB_XGEN(j)  (2304 + 64 * (j))
#define XB_TOP      3328
#define XB_TOPGEN   3392
#define XCD_BAR_WORDS 3456
#define XB_SPIN_CAP (1u << 24)
__device__ __forceinline__ unsigned xb_ld(unsigned* p)              { return __hip_atomic_load(p, __ATOMIC_RELAXED, __HIP_MEMORY_SCOPE_AGENT); }
__device__ __forceinline__ unsigned xb_add(unsigned* p, unsigned v) { return __hip_atomic_fetch_add(p, v, __ATOMIC_RELAXED, __HIP_MEMORY_SCOPE_AGENT); }
__device__ __forceinline__ unsigned xb_xcc_id() { return (unsigned)__builtin_amdgcn_s_getreg((3 << 11) | 20) & 0xFu; }
#define XB_SPIN(cond, bar) do { unsigned _sp = 0; while (cond) { __builtin_amdgcn_s_sleep(1); \
    if ((++_sp & 255u) == 0u) { if (xb_ld(&(bar)[XB_TMO])) break; if (_sp > XB_SPIN_CAP) { atomicAdd(&(bar)[XB_TMO], 1u); break; } } } } while (0)
struct XcdBarrier { unsigned* bar; unsigned x; volatile LAS unsigned* st; };
__device__ __forceinline__ XcdBarrier xcd_barrier_post(unsigned* bar, volatile LAS unsigned* st) {
    XcdBarrier b; b.bar = bar; b.x = xb_xcc_id(); b.st = st;
    if (threadIdx.x == 0) (void)xb_add(&bar[XB_XCNT(b.x)], 1u);
    return b;
}
__device__ __forceinline__ void xcd_barrier_complete(unsigned* bar, unsigned x, unsigned& nloc, unsigned& nx) {
    const unsigned G = gridDim.x * gridDim.y * gridDim.z;
    unsigned sum, cnt, mine, sp = 0u;
    for (;;) {
        sum = 0u; cnt = 0u; mine = 0u;
#pragma unroll
        for (unsigned j = 0; j < 16; ++j) { const unsigned c = xb_ld(&bar[XB_XCNT(j)]); sum += c; cnt += (c > 0u) ? 1u : 0u; mine = (j == x) ? c : mine; }
        if (sum == G) break;
        __builtin_amdgcn_s_sleep(1);
        if ((++sp & 255u) == 0u) { if (xb_ld(&bar[XB_TMO])) break; if (sp > XB_SPIN_CAP) { atomicAdd(&bar[XB_TMO], 1u); break; } }
    }
    nloc = mine > 0u ? mine : 1u; nx = cnt > 0u ? cnt : 1u;
}
__device__ __forceinline__ void xcd_barrier(const XcdBarrier& b) {
    asm volatile("s_waitcnt vmcnt(0)" ::: "memory");
    __syncthreads();
    if (threadIdx.x == 0) {
        unsigned* bar = b.bar;
        __builtin_amdgcn_s_waitcnt(0);
        unsigned nloc = b.st[0], nx = b.st[1];
        if (nloc == 0u) { xcd_barrier_complete(bar, b.x, nloc, nx); b.st[0] = nloc; b.st[1] = nx; }
        const unsigned old = xb_add(&bar[XB_XSUB(b.x)], 1u);
        const unsigned gen = old / nloc;
        if (old + 1u == (gen + 1u) * nloc) {
            __builtin_amdgcn_fence(__ATOMIC_RELEASE, "agent");
            asm volatile("s_waitcnt vmcnt(0)" ::: "memory");
            const unsigned og = xb_add(&bar[XB_TOP], 1u);
            const unsigned tg = og / nx;
            if (og + 1u == (tg + 1u) * nx) xb_add(&bar[XB_TOPGEN], 1u);
            else XB_SPIN(xb_ld(&bar[XB_TOPGEN]) == tg, bar);
            __builtin_amdgcn_fence(__ATOMIC_ACQUIRE, "agent");
            xb_add(&bar[XB_XGEN(b.x)], 1u);
            asm volatile("s_waitcnt vmcnt(0)" ::: "memory");
        } else {
            XB_SPIN(xb_ld(&bar[XB_XGEN(b.x)]) == gen, bar);
            __builtin_amdgcn_fence(__ATOMIC_ACQUIRE, "agent");
            asm volatile("s_waitcnt vmcnt(0)" ::: "memory");
        }
    }
    __syncthreads();
}

struct Args { const float* in[23]; float* out; unsigned char* ws; int ph_lo, ph_hi; };


struct TrDesc { const float* src; const float* gain; unsigned char* dst; int N, dpitch, k0, n0, mode, f8; float scale; };
constexpr int TR_HIN = 16 * 256, TR_HOUT = 16 * 64, TR_FG = 16 * 176, TR_FD = 44 * 64, TR_SIN = 16 * 128, TR_SOUT = 16 * 64, TR_MG = 16 * 224, TR_MD = 56 * 64;
constexpr int TR_NITEMS = TR_HIN + TR_HOUT + 2 * TR_FG + TR_FD + TR_SIN + TR_SOUT + 8 * (2 * TR_MG + TR_MD);
__device__ __forceinline__ void tr_set(TrDesc& d, const float* W, int K, int N, const float* gain, unsigned char* dst, int mode, int f8, float scale, int item) {
    const int nblk = N / 32, kb = item / nblk, nb = item - kb * nblk;
    d.src = W; d.gain = gain; d.dst = dst; d.N = N; d.dpitch = f8 ? K : 2 * K; d.k0 = 128 * kb; d.n0 = 32 * nb; d.mode = mode; d.f8 = f8; d.scale = scale;
}
__device__ __forceinline__ void tr_desc(const Args& a, int it, TrDesc& d) {
    unsigned char* ws = a.ws; int r = it;
    if (r < TR_HIN) { tr_set(d, a.in[3], 2048, 8192, a.in[2], ws + WS_W_HIN, 0, 2, I8_SW, r); return; } r -= TR_HIN;
    if (r < TR_HOUT) { tr_set(d, a.in[5], 2048, 2048, nullptr, ws + WS_W_HOUT, 0, 0, 1.f, r); return; } r -= TR_HOUT;
    if (r < TR_FG) { tr_set(d, a.in[7], 2048, DFF, a.in[6], ws + WS_W_FGU, 1, 2, I8_SW, r); return; } r -= TR_FG;
    if (r < TR_FG) { tr_set(d, a.in[8], 2048, DFF, a.in[6], ws + WS_W_FGU, 2, 2, I8_SW, r); return; } r -= TR_FG;
    if (r < TR_FD) { tr_set(d, a.in[9], DFF, 2048, nullptr, ws + WS_W_FD, 0, 0, 1.f, r); return; } r -= TR_FD;
    if (r < TR_SIN) { tr_set(d, a.in[11], 2048, 4096, a.in[10], ws + WS_W_SIN, 0, 2, I8_SW, r); return; } r -= TR_SIN;
    if (r < TR_SOUT) { tr_set(d, a.in[16], 2048, 2048, nullptr, ws + WS_W_SOUT, 0, 0, 1.f, r); return; } r -= TR_SOUT;
    if (r < 8 * TR_MG) { const int e = r / TR_MG; tr_set(d, a.in[19] + (size_t)e * 2048 * DFFE, 2048, DFFE, a.in[17], ws + WS_W_MGU + (size_t)e * 2 * DFFE * 2048, 1, 1, F8_SW_UP, r - e * TR_MG); return; } r -= 8 * TR_MG;
    if (r < 8 * TR_MG) { const int e = r / TR_MG; tr_set(d, a.in[20] + (size_t)e * 2048 * DFFE, 2048, DFFE, a.in[17], ws + WS_W_MGU + (size_t)e * 2 * DFFE * 2048, 2, 1, F8_SW_UP, r - e * TR_MG); return; } r -= 8 * TR_MG;
    { const int e = r / TR_MD; tr_set(d, a.in[21] + (size_t)e * DFFE * 2048, DFFE, 2048, nullptr, ws + WS_W_MD + (size_t)e * 2048 * DFFE, 0, 1, F8_SW_DN, r - e * TR_MD); }
}
__device__ __forceinline__ void tr_load(const TrDesc& d, f32x4 (&v)[16], float (&g)[16], int lane) {
    const int r = lane >> 3, c4 = lane & 7; const float* base = d.src + (size_t)(d.k0 + r) * d.N + d.n0 + 4 * c4; const size_t step = (size_t)8 * d.N;
#pragma unroll
    for (int i = 0; i < 16; ++i) v[i] = __builtin_nontemporal_load((const f32x4*)(base + i * step));
#pragma unroll
    for (int i = 0; i < 16; ++i) g[i] = d.gain ? d.gain[d.k0 + 8 * i + r] : 1.f;
}
__device__ __forceinline__ void tr_process(const TrDesc& d, const f32x4 (&v)[16], const float (&g)[16], LAS float* scr, int lane) {
    { const int r = lane >> 3, c4 = lane & 7;
#pragma unroll
      for (int i = 0; i < 16; ++i) { const float s = g[i] * d.scale; LAS float* p = scr + (8 * i + r) * 33 + 4 * c4; p[0] = v[i].x * s; p[1] = v[i].y * s; p[2] = v[i].z * s; p[3] = v[i].w * s; } }
    LDS_WAIT(); asm volatile("" ::: "memory");
    const int c = lane & 15, nn = lane >> 4;
#pragma unroll
    for (int t = 0; t < 8; ++t) { const int n = nn + 4 * t; const LAS float* s = scr + (8 * c) * 33 + n;
        const int gn = d.n0 + n; const int row = d.mode == 0 ? gn : (gn >> 7) * 256 + (d.mode - 1) * 128 + (gn & 127);
        unsigned char* o = d.dst + (size_t)row * d.dpitch;
        if (d.f8 == 2) { v2u w; w.x = pg8::pk4_i8(s[0 * 33], s[1 * 33], s[2 * 33], s[3 * 33]); w.y = pg8::pk4_i8(s[4 * 33], s[5 * 33], s[6 * 33], s[7 * 33]); *(v2u*)(o + d.k0 + 8 * c) = w; }
        else if (d.f8) { v2u w; w.x = pg8::pk4_fp8(s[0 * 33], s[1 * 33], s[2 * 33], s[3 * 33]); w.y = pg8::pk4_fp8(s[4 * 33], s[5 * 33], s[6 * 33], s[7 * 33]); *(v2u*)(o + d.k0 + 8 * c) = w; }
        else { v4u w; w.x = pk2(s[0 * 33], s[1 * 33]); w.y = pk2(s[2 * 33], s[3 * 33]); w.z = pk2(s[4 * 33], s[5 * 33]); w.w = pk2(s[6 * 33], s[7 * 33]); *(v4u*)(o + 2 * (d.k0 + 8 * c)) = w; } }
    asm volatile("" ::: "memory");
}

__device__ __forceinline__ void p0_prologue(const Args& a, LAS unsigned char* lds, int vcu, int G, int wave, int lane) {
    unsigned char* ws = a.ws;
    LAS float* scr = (LAS float*)(lds + wave * 16896);
    const int gw = vcu * NWAVES + wave, NGW = G * NWAVES;
    { const float* x = a.in[0]; unsigned char* xq = ws + WS_R + 128 * MiB;
      for (int m = gw; m < M; m += NGW) {
          const f32x4* xr = (const f32x4*)(x + (size_t)m * D) + 2 * lane; f32x4 v[8]; float s = 0.f;
#pragma unroll
          for (int q = 0; q < 4; ++q) { v[2 * q] = xr[128 * q]; v[2 * q + 1] = xr[128 * q + 1];
              s += ((v[2 * q].x * v[2 * q].x + v[2 * q].y * v[2 * q].y) + (v[2 * q].z * v[2 * q].z + v[2 * q].w * v[2 * q].w)) + ((v[2 * q + 1].x * v[2 * q + 1].x + v[2 * q + 1].y * v[2 * q + 1].y) + (v[2 * q + 1].z * v[2 * q + 1].z + v[2 * q + 1].w * v[2 * q + 1].w)); }
          const float sc = I8_SA / sqrtf(wave_sum(s) * (1.0f / 2048.0f) + EPS);
          v2u* o = (v2u*)(xq + (size_t)m * D) + lane;
#pragma unroll
          for (int q = 0; q < 4; ++q) o[64 * q] = (v2u){pg8::pk4_i8(v[2 * q].x * sc, v[2 * q].y * sc, v[2 * q].z * sc, v[2 * q].w * sc), pg8::pk4_i8(v[2 * q + 1].x * sc, v[2 * q + 1].y * sc, v[2 * q + 1].z * sc, v[2 * q + 1].w * sc)}; } }
    { const float* lg = a.in[1]; float* lb = (float*)(ws + WS_LB);
      for (int c = gw * 64 + lane; c < 2048; c += NGW * 64) { const float l0 = lg[c], l1 = lg[2048 + c], l2 = lg[4096 + c], mx = fmaxf(l0, fmaxf(l1, l2));
          const float e0 = __expf(l0 - mx), e1 = __expf(l1 - mx), e2 = __expf(l2 - mx); lb[c] = e0 / (e0 + e1 + e2); }
      int* rt = (int*)(ws + WS_ROWTOK); float* rw = (float*)(ws + WS_ROWW); float* rr = (float*)(ws + WS_ROWRS);
      for (int i = gw * 64 + lane; i < 2 * SROWS; i += NGW * 64) { rt[i] = -1; rw[i] = 0.f; rr[i] = 0.f; } }
    TrDesc cur, nxt; f32x4 cv[16], nv[16]; float cg[16], ng[16];
    int it = gw; bool have = it < TR_NITEMS;
    if (have) { tr_desc(a, it, cur); tr_load(cur, cv, cg, lane); }
    while (have) {
        const int itn = it + NGW; const bool hn = itn < TR_NITEMS;
        if (hn) { tr_desc(a, itn, nxt); tr_load(nxt, nv, ng, lane); }
        tr_process(cur, cv, cg, scr, lane);
        cur = nxt; it = itn; have = hn;
#pragma unroll
        for (int i = 0; i < 16; ++i) { cv[i] = nv[i]; cg[i] = ng[i]; }
    }
}

#define MFMA32(a, b, c) __builtin_amdgcn_mfma_f32_32x32x16_bf16((a), (b), (c), 0, 0, 0)
template <int KSTEPS> __device__ __forceinline__ void mma_img(f32x16& acc, const LAS unsigned char* A, int pa, int m0, const LAS unsigned char* B, int pb, int n0, int lane) {
    const int r = lane & 31, h = lane >> 5; const LAS unsigned char* ap = A + (m0 + r) * pa + 16 * h; const LAS unsigned char* bp = B + (n0 + r) * pb + 16 * h;
#pragma unroll
    for (int s = 0; s < KSTEPS; ++s) { const bf16x8 av = *(const LAS bf16x8*)(ap + 32 * s), bv = *(const LAS bf16x8*)(bp + 32 * s); acc = MFMA32(av, bv, acc); }
}
constexpr int SC_P128 = 272, SC_P64 = 144;
constexpr int SC_KI = 0, SC_QI = 17408, SC_QE = 34816, SC_ST = 52224, SC_VT = 87040, SC_KST = 105472, SC_P = 123904, SC_DEC = 133120, SC_CSUM = 133632  , SC_RED = 137728, SC_NG = 138752, SC_END = 139264;
static_assert(SC_END <= MISC_OFF, "scan LDS");

__device__ __forceinline__ void hgrn_scan_unit(LAS unsigned char* lds, int bh, const bf16* Qg, const bf16* Kg, const bf16* Gg, const bf16* Ig, const bf16* Gtg, bf16* Og, const float* normg, int tid) {
    const int lane = tid & 63, wave = tid >> 6, b = bh >> 4, hh = bh & 15;
    const int r = lane & 31, h2 = lane >> 5;
    const size_t gbase = (size_t)b * SEQ * 2048 + hh * 128;
    for (int i = tid; i < 34816 / 16; i += 512) *(LAS v4u*)(lds + SC_ST + 16 * i) = (v4u){0u, 0u, 0u, 0u};
    if (tid < 128) ((LAS float*)(lds + SC_NG))[tid] = normg[hh * 128 + tid];
    f32x16 S0, S1;
#pragma unroll
    for (int i = 0; i < 16; ++i) { S0[i] = 0.f; S1[i] = 0.f; }
    const int dkp = tid & 63, dk0 = 2 * dkp, tq8 = wave;
    unsigned cq[8], cg[8], cv[8];
    { const size_t o = gbase + (size_t)(8 * tq8) * 2048 + dk0;
#pragma unroll
      for (int i = 0; i < 8; ++i) { cq[i] = *(const unsigned*)(Qg + o + (size_t)i * 2048); cg[i] = *(const unsigned*)(Gg + o + (size_t)i * 2048); cv[i] = *(const unsigned*)(Ig + o + (size_t)i * 2048); } }
    WG_BAR();
    for (int c = 0; c < NCH; ++c) {
        unsigned nq[8], ng[8], nv[8];
        { const int cn = (c + 1 < NCH) ? c + 1 : c; const size_t o = gbase + (size_t)(64 * cn + 8 * tq8) * 2048 + dk0;
#pragma unroll
          for (int i = 0; i < 8; ++i) { nq[i] = *(const unsigned*)(Qg + o + (size_t)i * 2048); ng[i] = *(const unsigned*)(Gg + o + (size_t)i * 2048); nv[i] = *(const unsigned*)(Ig + o + (size_t)i * 2048); } }
        v2u gtv[4];
        { const size_t orow_ = gbase + (size_t)(64 * c + 32 * (wave & 1) + r) * 2048 + 32 * (wave >> 1) + 4 * h2;
#pragma unroll
          for (int g4 = 0; g4 < 4; ++g4) gtv[g4] = *(const v2u*)(Gtg + orow_ + 8 * g4); }
        float bl0[8], bl1[8]; { float r0 = 0.f, r1 = 0.f;
#pragma unroll
          for (int i = 0; i < 8; ++i) { r0 += bflo(cg[i]); r1 += bfhi(cg[i]); bl0[i] = r0; bl1[i] = r1; }
          *(LAS pg8::f32x2*)(lds + SC_CSUM + 4 * (tq8 * 128 + dk0)) = (pg8::f32x2){r0, r1}; }
        WG_BAR();
        { float pre0 = 0.f, pre1 = 0.f, mid0 = 0.f, mid1 = 0.f, tot0 = 0.f, tot1 = 0.f;
#pragma unroll
          for (int q8 = 0; q8 < 8; ++q8) { const pg8::f32x2 cs = *(const LAS pg8::f32x2*)(lds + SC_CSUM + 4 * (q8 * 128 + dk0));
              if (q8 < tq8) { pre0 += cs.x; pre1 += cs.y; } if (q8 < 4) { mid0 += cs.x; mid1 += cs.y; } tot0 += cs.x; tot1 += cs.y; }
          const float A10 = __expf(-mid0), A11 = __expf(-mid1), A20 = __expf(mid0), A21 = __expf(mid1), Dc0 = __expf(tot0), Dc1 = __expf(tot1);
          if (tq8 == 0) *(LAS pg8::f32x2*)(lds + SC_DEC + 4 * dk0) = (pg8::f32x2){Dc0, Dc1};
          float ks0[8], ks1[8];
#pragma unroll
          for (int i = 0; i < 8; ++i) {
              const int t = 8 * tq8 + i;
              const float E0 = __expf(fmaxf(pre0 + bl0[i], -80.f)), E1 = __expf(fmaxf(pre1 + bl1[i], -80.f)), rE0 = __builtin_amdgcn_rcpf(E0), rE1 = __builtin_amdgcn_rcpf(E1);
              const float q0 = bflo(cq[i]), q1 = bfhi(cq[i]), k0 = 1.0f - __expf(bflo(cg[i])), k1 = 1.0f - __expf(bfhi(cg[i]));
              const float qe0 = q0 * E0, qe1 = q1 * E1, kr0 = k0 * rE0, kr1 = k1 * rE1;
              *(LAS unsigned*)(lds + SC_QI + t * SC_P128 + 4 * dkp) = pk2(qe0 * A10, qe1 * A11);
              *(LAS unsigned*)(lds + SC_KI + t * SC_P128 + 4 * dkp) = pk2(kr0 * A20, kr1 * A21);
              *(LAS unsigned*)(lds + SC_QE + t * SC_P128 + 4 * dkp) = pk2(qe0, qe1);
              ks0[i] = kr0 * Dc0; ks1[i] = kr1 * Dc1; }
          *(LAS v4u*)(lds + SC_KST + dk0 * SC_P64 + 16 * tq8) = (v4u){pk2(ks0[0], ks0[1]), pk2(ks0[2], ks0[3]), pk2(ks0[4], ks0[5]), pk2(ks0[6], ks0[7])};
          *(LAS v4u*)(lds + SC_KST + (dk0 + 1) * SC_P64 + 16 * tq8) = (v4u){pk2(ks1[0], ks1[1]), pk2(ks1[2], ks1[3]), pk2(ks1[4], ks1[5]), pk2(ks1[6], ks1[7])};
          *(LAS v4u*)(lds + SC_VT + dk0 * SC_P64 + 16 * tq8) = (v4u){(cv[0] & 0xffffu) | (cv[1] << 16), (cv[2] & 0xffffu) | (cv[3] << 16), (cv[4] & 0xffffu) | (cv[5] << 16), (cv[6] & 0xffffu) | (cv[7] << 16)};
          *(LAS v4u*)(lds + SC_VT + (dk0 + 1) * SC_P64 + 16 * tq8) = (v4u){(cv[0] >> 16) | (cv[1] & 0xffff0000u), (cv[2] >> 16) | (cv[3] & 0xffff0000u), (cv[4] >> 16) | (cv[5] & 0xffff0000u), (cv[6] >> 16) | (cv[7] & 0xffff0000u)}; }
        WG_BAR();
        const int dm = wave >> 1, tn = wave & 1;
        f32x16 oacc;
#pragma unroll
        for (int i = 0; i < 16; ++i) oacc[i] = 0.f;
        mma_img<8>(oacc, lds + SC_ST, SC_P128, 32 * dm, lds + SC_QE, SC_P128, 32 * tn, lane);
        if (wave < 4) {
            const int sm = wave >> 1, xn = wave & 1; f32x16 x;
#pragma unroll
            for (int i = 0; i < 16; ++i) x[i] = 0.f;
            mma_img<8>(x, lds + SC_KI, SC_P128, 32 * sm, lds + SC_QI, SC_P128, 32 * xn, lane);
            const int t = 32 * xn + r;
#pragma unroll
            for (int g4 = 0; g4 < 4; ++g4) { const int s0 = 32 * sm + 8 * g4 + 4 * h2; float v[4];
#pragma unroll
                for (int j = 0; j < 4; ++j) v[j] = (t >= s0 + j) ? x[4 * g4 + j] : 0.f;
                *(LAS v2u*)(lds + SC_P + t * SC_P64 + 2 * s0) = (v2u){pk2(v[0], v[1]), pk2(v[2], v[3])}; }
        }
        WG_BAR();
        mma_img<4>(oacc, lds + SC_VT, SC_P64, 32 * dm, lds + SC_P, SC_P64, 32 * tn, lane);
        { const int km = wave >> 1, vn0 = 2 * (wave & 1);
#pragma unroll
          for (int g4 = 0; g4 < 4; ++g4) { const f32x4 dc = *(const LAS f32x4*)(lds + SC_DEC + 4 * (32 * km + 8 * g4 + 4 * h2));
#pragma unroll
              for (int j = 0; j < 4; ++j) { S0[4 * g4 + j] *= dc[j]; S1[4 * g4 + j] *= dc[j]; } }
          mma_img<4>(S0, lds + SC_KST, SC_P64, 32 * km, lds + SC_VT, SC_P64, 32 * vn0, lane);
          mma_img<4>(S1, lds + SC_KST, SC_P64, 32 * km, lds + SC_VT, SC_P64, 32 * (vn0 + 1), lane); }
        { float ss = 0.f;
#pragma unroll
          for (int i = 0; i < 16; ++i) ss += oacc[i] * oacc[i];
          ss += __shfl_xor(ss, 32);
          if (h2 == 0) ((LAS float*)(lds + SC_RED))[dm * 64 + 32 * tn + r] = ss; }
        WG_BAR();
        { const int km = wave >> 1, vn0 = 2 * (wave & 1);
#pragma unroll
          for (int g4 = 0; g4 < 4; ++g4) { const int dk0 = 32 * km + 8 * g4 + 4 * h2;
              *(LAS v2u*)(lds + SC_ST + (32 * vn0 + r) * SC_P128 + 2 * dk0) = (v2u){pk2(S0[4 * g4], S0[4 * g4 + 1]), pk2(S0[4 * g4 + 2], S0[4 * g4 + 3])};
              *(LAS v2u*)(lds + SC_ST + (32 * (vn0 + 1) + r) * SC_P128 + 2 * dk0) = (v2u){pk2(S1[4 * g4], S1[4 * g4 + 1]), pk2(S1[4 * g4 + 2], S1[4 * g4 + 3])}; } }
        { const int t = 32 * tn + r; const LAS float* rd = (const LAS float*)(lds + SC_RED);
          const float tot = (rd[t] + rd[64 + t]) + (rd[128 + t] + rd[192 + t]), rinv = 1.0f / sqrtf(tot * (1.0f / 128.0f) + EPS);
          const size_t orow = gbase + (size_t)(64 * c + t) * 2048;
#pragma unroll
          for (int g4 = 0; g4 < 4; ++g4) { const int dv0 = 32 * dm + 8 * g4 + 4 * h2;
              const f32x4 ng4 = *(const LAS f32x4*)(lds + SC_NG + 4 * dv0); const v2u gt = gtv[g4];
              const float o0 = oacc[4 * g4] * rinv * ng4[0] * bflo(gt.x), o1 = oacc[4 * g4 + 1] * rinv * ng4[1] * bfhi(gt.x), o2 = oacc[4 * g4 + 2] * rinv * ng4[2] * bflo(gt.y), o3 = oacc[4 * g4 + 3] * rinv * ng4[3] * bfhi(gt.y);
              *(v2u*)(Og + orow + dv0) = (v2u){pk2(o0, o1), pk2(o2, o3)}; } }
#pragma unroll
        for (int i = 0; i < 8; ++i) { cq[i] = nq[i]; cg[i] = ng[i]; cv[i] = nv[i]; }
        WG_BAR();
    }
}

constexpr int SG_WM = 0, SG_VT = 34816, SG_MR = 69632, SG_END = 70656;
__device__ __forceinline__ void sgu_load_wm(LAS unsigned char* lds, const float* ws_g, int tid) {
    for (int i = tid; i < 128 * 32; i += 512) { const int t = i >> 5, s4 = (i & 31) * 4; f32x4 w = *(const f32x4*)(ws_g + t * 128 + s4);
        if (t < 64 && s4 >= 64) w = (f32x4){0.f, 0.f, 0.f, 0.f};
        *(LAS v2u*)(lds + SG_WM + t * SC_P128 + 2 * s4) = (v2u){pk2(w[0], w[1]), pk2(w[2], w[3])}; }
}
struct SguPre { unsigned raw[16]; float s1, s2; };
__device__ __forceinline__ void sgu_load(const bf16* V, const pg8::u64* stats, int bn, int g, int tid, SguPre& p) {
    const int cp = tid & 63, sq = tid >> 6; const bf16* vp = V + ((size_t)bn * 128 + 16 * sq) * 2048 + 128 * g + 2 * cp;
#pragma unroll
    for (int i = 0; i < 16; ++i) p.raw[i] = *(const unsigned*)(vp + (size_t)i * 2048);
    p.s1 = 0.f; p.s2 = 0.f;
    if (tid < 128) { p.s1 = pg8::fx_get(stats + 2 * ((size_t)bn * 128 + tid)); p.s2 = pg8::fx_get(stats + 2 * ((size_t)bn * 128 + tid) + 1); }
}
__device__ __forceinline__ void sgu_unit(LAS unsigned char* lds, int bn, int g, const bf16* U, bf16* Uo, const SguPre& cur, const bf16* V, const pg8::u64* stats, int nbn, int ng, SguPre& nxt,
                                         pg8::f32x2 gg, pg8::f32x2 bb, float bias0, float bias1, int tid) {
    const int lane = tid & 63, wave = tid >> 6, r = lane & 31, h2 = lane >> 5;
    const size_t row0 = (size_t)bn * 128;
    if (tid < 128) { const float mean = cur.s1 * (1.0f / 2048.0f), var = fmaxf(cur.s2 * (1.0f / 2048.0f) - mean * mean, 0.f);
        ((LAS float*)(lds + SG_MR))[2 * tid] = mean; ((LAS float*)(lds + SG_MR))[2 * tid + 1] = 1.0f / sqrtf(var + EPS); }
    WG_BAR();
    { const int cp = tid & 63, sq = tid >> 6, c0 = 2 * cp;
      unsigned pk0[8], pk1[8];
#pragma unroll
      for (int i = 0; i < 16; i += 2) { const int s = 16 * sq + i; const pg8::f32x4 mr = *(const LAS pg8::f32x4*)(lds + SG_MR + 8 * s);
          const float a0 = (bflo(cur.raw[i]) - mr[0]) * mr[1] * gg.x + bb.x, a1 = (bflo(cur.raw[i + 1]) - mr[2]) * mr[3] * gg.x + bb.x;
          const float b0 = (bfhi(cur.raw[i]) - mr[0]) * mr[1] * gg.y + bb.y, b1 = (bfhi(cur.raw[i + 1]) - mr[2]) * mr[3] * gg.y + bb.y;
          pk0[i >> 1] = pk2(a0, a1); pk1[i >> 1] = pk2(b0, b1); }
      *(LAS v4u*)(lds + SG_VT + c0 * SC_P128 + 32 * sq) = (v4u){pk0[0], pk0[1], pk0[2], pk0[3]};
      *(LAS v4u*)(lds + SG_VT + c0 * SC_P128 + 32 * sq + 16) = (v4u){pk0[4], pk0[5], pk0[6], pk0[7]};
      *(LAS v4u*)(lds + SG_VT + (c0 + 1) * SC_P128 + 32 * sq) = (v4u){pk1[0], pk1[1], pk1[2], pk1[3]};
      *(LAS v4u*)(lds + SG_VT + (c0 + 1) * SC_P128 + 32 * sq + 16) = (v4u){pk1[4], pk1[5], pk1[6], pk1[7]}; }
    WG_BAR();
    sgu_load(V, stats, nbn, ng, tid, nxt);
    const int cm = wave >> 1;
#pragma unroll
    for (int jj = 0; jj < 2; ++jj) { const int tn = 2 * (wave & 1) + jj; f32x16 acc;
#pragma unroll
        for (int i = 0; i < 16; ++i) acc[i] = 0.f;
        mma_img<8>(acc, lds + SG_VT, SC_P128, 32 * cm, lds + SG_WM, SC_P128, 32 * tn, lane);
        const int t = 32 * tn + r; const float bias = jj ? bias1 : bias0; const bf16* up = U + (row0 + t) * 2048 + 128 * g; bf16* uo = Uo + (row0 + t) * 2048 + 128 * g;
#pragma unroll
        for (int g4 = 0; g4 < 4; ++g4) { const int c0 = 32 * cm + 8 * g4 + 4 * h2; const v2u uu = *(const v2u*)(up + c0);
            const float o0 = (acc[4 * g4] + bias) * bflo(uu.x), o1 = (acc[4 * g4 + 1] + bias) * bfhi(uu.x), o2 = (acc[4 * g4 + 2] + bias) * bflo(uu.y), o3 = (acc[4 * g4 + 3] + bias) * bfhi(uu.y);
            *(v2u*)(uo + c0) = (v2u){pk2(o0, o1), pk2(o2, o3)}; } }
    WG_BAR();
}

constexpr int RT_W = 0, RT_LCNT = 65536, RT_BASE = RT_LCNT + 64, RT_E = RT_BASE + 64, RT_LP = RT_E + 1024, RT_END = RT_LP + 1024;
__device__ __forceinline__ void router_phase(const Args& a, LAS unsigned char* lds, int G, int tid) {
    unsigned char* ws = a.ws; const int lane = tid & 63, wave = tid >> 6;
    const bf16* x2 = (const bf16*)(ws + WS_XB);     unsigned char* xb8 = ws + WS_R + R_H;     const float* gain = a.in[17]; const float* wr = a.in[18];
    unsigned* gcnt = (unsigned*)(ws + WS_CTL) + CW_CNT;
    int* tok_e = (int*)(ws + WS_TOKE); int* tok_p = (int*)(ws + WS_TOKP); float* tok_w = (float*)(ws + WS_TOKW); float* tok_rs = (float*)(ws + WS_TOKRS);
    LAS float* wrT = (LAS float*)(lds + RT_W); LAS int* lcnt = (LAS int*)(lds + RT_LCNT); LAS int* lbase = (LAS int*)(lds + RT_BASE); LAS int* le = (LAS int*)(lds + RT_E); LAS int* lp = (LAS int*)(lds + RT_LP);
    for (int i = tid; i < 2048 * 8; i += 512) { const int k = i >> 3, e = i & 7; wrT[e * 2048 + k] = wr[i] * gain[k]; }
    if (tid < 16) lcnt[tid] = 0;
    WG_BAR();
    for (int t0 = blockIdx.x * 128; t0 < M; t0 += G * 128) {
        v2u nx[8];
        { const int t = t0 + wave * 16; const v2u* xr = (const v2u*)(x2 + (size_t)t * D) + lane;
#pragma unroll
          for (int jj = 0; jj < 8; ++jj) nx[jj] = xr[64 * jj]; }
        for (int j = 0; j < 16; ++j) {
            const int ti = wave * 16 + j, t = t0 + ti;
            float acc[8], ss = 0.f; f32x4 xa[8];
#pragma unroll
            for (int jj = 0; jj < 8; ++jj) { const v2u xq = nx[jj]; xa[jj] = (f32x4){bflo(xq.x), bfhi(xq.x), bflo(xq.y), bfhi(xq.y)}; }
            { const int tn = t0 + wave * 16 + (j < 15 ? j + 1 : j); const v2u* xr = (const v2u*)(x2 + (size_t)tn * D) + lane;
#pragma unroll
              for (int jj = 0; jj < 8; ++jj) nx[jj] = xr[64 * jj]; }
#pragma unroll
            for (int e = 0; e < 8; ++e) acc[e] = 0.f;
#pragma unroll
            for (int jj = 0; jj < 8; ++jj) { const f32x4 xv = xa[jj]; ss += (xv.x * xv.x + xv.y * xv.y) + (xv.z * xv.z + xv.w * xv.w);
#pragma unroll
                for (int e = 0; e < 8; ++e) { const f32x4 w4 = *(const LAS f32x4*)(wrT + e * 2048 + 4 * lane + 256 * jj); acc[e] += (xv.x * w4.x + xv.y * w4.y) + (xv.z * w4.z + xv.w * w4.w); } }
            ss = wave_sum(ss);
#pragma unroll
            for (int e = 0; e < 8; ++e) acc[e] = wave_sum(acc[e]);
            const float rs = 1.0f / sqrtf(ss * (1.0f / 2048.0f) + EPS);
            { const float sc = rs * F8_SA; unsigned* dst = (unsigned*)(xb8 + (size_t)t * D) + lane;
#pragma unroll
              for (int jj = 0; jj < 8; ++jj) dst[64 * jj] = pg8::pk4_fp8(xa[jj].x * sc, xa[jj].y * sc, xa[jj].z * sc, xa[jj].w * sc); }
            float v1 = -3.0e38f, v2 = -3.0e38f; int i1 = 0, i2 = 0;
#pragma unroll
            for (int e = 0; e < 8; ++e) { const float l = acc[e] * rs; if (l > v1) { v2 = v1; i2 = i1; v1 = l; i1 = e; } else if (l > v2) { v2 = l; i2 = e; } }
            if (lane == 0) {
                const float ex = __expf(v2 - v1), w1 = 1.0f / (1.0f + ex), w2 = ex * w1;
                tok_w[t] = w1; tok_w[M + t] = w2; tok_rs[t] = rs;
                le[ti] = i1; le[128 + ti] = i2;
                lp[ti] = __hip_atomic_fetch_add(lcnt + i1, 1, __ATOMIC_RELAXED, __HIP_MEMORY_SCOPE_WORKGROUP);
                lp[128 + ti] = __hip_atomic_fetch_add(lcnt + 8 + i2, 1, __ATOMIC_RELAXED, __HIP_MEMORY_SCOPE_WORKGROUP);
            }
        }
        WG_BAR();
        if (tid < 16) { lbase[tid] = (int)__hip_atomic_fetch_add(gcnt + 64 * tid, (unsigned)lcnt[tid], __ATOMIC_RELAXED, __HIP_MEMORY_SCOPE_AGENT); lcnt[tid] = 0; }
        WG_BAR();
        if (tid < 256) { const int k = tid >> 7, ti = tid & 127, e = le[k * 128 + ti]; tok_e[k * M + t0 + ti] = e; tok_p[k * M + t0 + ti] = lbase[8 * k + e] + lp[k * 128 + ti]; }
        WG_BAR();
    }
}
__device__ __forceinline__ void moe_offsets(const Args& a, volatile LAS int* off, volatile LAS int* npan, int tid) {
    if (tid == 0) { const unsigned* gcnt = (const unsigned*)(a.ws + WS_CTL) + CW_CNT; int o = 0;
        for (int e = 0; e < 8; ++e) { const int n0 = (int)__hip_atomic_load(gcnt + 64 * e, __ATOMIC_RELAXED, __HIP_MEMORY_SCOPE_AGENT), n1 = (int)__hip_atomic_load(gcnt + 64 * (8 + e), __ATOMIC_RELAXED, __HIP_MEMORY_SCOPE_AGENT);
            off[16 + e] = o; off[e] = o; off[8 + e] = o + n0; o += ((n0 + n1 + 255) >> 8) << 8; }
        npan[0] = 0; npan[1] = o >> 8; }
    WG_BAR();
}
__device__ __forceinline__ void assign_phase(const Args& a, volatile LAS int* off, volatile LAS int* npan, int vcu, int G, int tid) {
    unsigned char* ws = a.ws; const int lane = tid & 63, wave = tid >> 6;
    moe_offsets(a, off, npan, tid);
    if (blockIdx.x == 0 && tid < 320) { const int p = tid; int* pe = (int*)(ws + WS_PANE);
        if (p < npan[1]) { int j = 0; for (int q = 1; q < 8; ++q) if (p * 256 >= off[16 + q]) j = q; pe[p] = j; }
        if (p == 0) ((int*)(ws + WS_NPAN))[0] = npan[1]; }
    const int* tok_e = (const int*)(ws + WS_TOKE); const int* tok_p = (const int*)(ws + WS_TOKP); const float* tok_w = (const float*)(ws + WS_TOKW);
    int* row_tok = (int*)(ws + WS_ROWTOK); float* row_w = (float*)(ws + WS_ROWW);
    const unsigned char* xb8 = ws + WS_R + R_H; unsigned char* AS = ws + WS_R + R_AS;
    const int gw = vcu * NWAVES + wave, NGW = G * NWAVES;
    for (int t0 = gw; t0 < M; t0 += 4 * NGW) {
        v4u q0[4], q1[4]; int pp[4][2]; float ww[4][2];
#pragma unroll
        for (int i = 0; i < 4; ++i) { const int t = t0 + i * NGW; const bool ok = t < M; const int tt = ok ? t : t0;
            const v4u* src = (const v4u*)(xb8 + (size_t)tt * D) + lane; q0[i] = src[0]; q1[i] = src[64];
#pragma unroll
            for (int k = 0; k < 2; ++k) { const int e = tok_e[k * M + tt]; pp[i][k] = off[8 * k + e] + tok_p[k * M + tt]; ww[i][k] = tok_w[k * M + tt]; } }
#pragma unroll
        for (int i = 0; i < 4; ++i) { const int t = t0 + i * NGW; if (t < M) {
#pragma unroll
            for (int k = 0; k < 2; ++k) { const int p = pp[i][k];
                if (lane == 0) { __hip_atomic_store(row_tok + p, k * M + t, __ATOMIC_RELAXED, __HIP_MEMORY_SCOPE_AGENT); __hip_atomic_store(row_w + p, ww[i][k], __ATOMIC_RELAXED, __HIP_MEMORY_SCOPE_AGENT); }
                v4u* dst = (v4u*)(AS + (size_t)p * D) + lane; dst[0] = q0[i]; dst[64] = q1[i]; } } }
    }
}

__device__ __forceinline__ Args ldargs() {
#if defined(__HIP_DEVICE_COMPILE__)
    const __attribute__((address_space(4))) unsigned char* p = (const __attribute__((address_space(4))) unsigned char*)__builtin_amdgcn_kernarg_segment_ptr(); asm volatile("" : "+s"(p));
    Args a; __builtin_memcpy(&a, (const unsigned char*)p, sizeof(Args)); return a;
#else
    return Args{};
#endif
}
__global__ void __launch_bounds__(NWAVES * 64, 2) trunk_fwd(Args kargs) {
    extern __shared__ __attribute__((aligned(16))) unsigned char lds_raw[];
    LAS unsigned char* lds = (LAS unsigned char*)lds_raw;
    volatile LAS unsigned* MISC = (volatile LAS unsigned*)(lds + MISC_OFF);
    const int wave = __builtin_amdgcn_readfirstlane((int)threadIdx.x >> 6);
#define LANE() ((int)__builtin_amdgcn_mbcnt_hi(~0u, __builtin_amdgcn_mbcnt_lo(~0u, 0u)))
#define TIDX() (wave * 64 + LANE())
    const int G = gridDim.x; const int bx = blockIdx.x; const int vcu = (G % 8 == 0) ? (bx % 8) * (G / 8) + bx / 8 : bx;
    unsigned char* ws = kargs.ws;
    unsigned* ctl = (unsigned*)(ws + WS_CTL);
    if (threadIdx.x < 64) MISC[threadIdx.x] = 0u;
    __syncthreads();
    XcdBarrier bar; bar.bar = ctl + CW_BAR; bar.x = 0; bar.st = nullptr;
#if !MK_PER_PHASE
    bar = xcd_barrier_post(ctl + CW_BAR, MISC + 8);
#define GRID_BAR() xcd_barrier(bar)
#else
#define GRID_BAR() do { } while (0)
#endif
    const int lo = kargs.ph_lo, hi = kargs.ph_hi;
#ifndef PH_MASK
#define PH_MASK 0xFFFF
#endif
#define IN(k) ((((PH_MASK) >> (k)) & 1) && lo <= (k) && (k) < hi)
#define BOTH(k) (IN(k) && IN((k) + 1))
    using namespace pg8;
    bf16* xb = (bf16*)(ws + WS_XB);
    float* out = kargs.out;

#ifndef PROBE
#define PROBE 0
#endif
#define REPS(k) _Pragma("nounroll") for (int rep = ((PROBE >> (k)) & 1) ? 0 : 1; rep < 2; ++rep)
    if (IN(0)) { const Args args = ldargs(); REPS(0) { p0_prologue(args, lds, vcu, G, wave, LANE()); if (BOTH(0)) GRID_BAR(); } }

    if (IN(1)) {
        Gemm g{(const bf16*)(ws + WS_R + 128 * MiB), (const bf16*)(ws + WS_W_HIN), M, 8192, 1024, 0}; StaticOrder S; S.init(M, 8192, G, bx);
        EpiHgrnIn E{1.0f / (I8_SA * I8_SW), (const float*)(ws + WS_LB), (bf16*)(ws + WS_R + R_Q), (bf16*)(ws + WS_R + R_G), (bf16*)(ws + WS_R + R_I), (bf16*)(ws + WS_R + R_GT)};
        REPS(1) { gemm_phase<EpiHgrnIn, StaticOrder, true, true, false, true>(lds, g, S, E, wave);
        if (BOTH(1)) GRID_BAR(); }
    }
    if (IN(2)) {
        const Args args = ldargs();
        REPS(2) { for (int bh = bx; bh < BATCH * NH; bh += G)
            hgrn_scan_unit(lds, bh, (const bf16*)(ws + WS_R + R_Q), (const bf16*)(ws + WS_R + R_K), (const bf16*)(ws + WS_R + R_G), (const bf16*)(ws + WS_R + R_I), (const bf16*)(ws + WS_R + R_GT), (bf16*)(ws + WS_O), args.in[4], TIDX());
        if (BOTH(2)) GRID_BAR(); }
    }
    if (IN(3)) {
        const Args args = ldargs();
        Gemm g{(const bf16*)(ws + WS_O), (const bf16*)(ws + WS_W_HOUT), M, 2048, 2048, 0}; StaticOrder S; S.init(M, 2048, G, bx);
        REPS(3) { EpiResid<false, false> E{args.in[0], nullptr, nullptr, rep ? xb : (bf16*)(ws + WS_R + 384 * MiB), (u64*)(rep ? ws + WS_RSS1 : ws + WS_R + 512 * MiB), ws + WS_R + 640 * MiB, I8_SA_X1};
        gemm_phase<EpiResid<false, false>, StaticOrder, true, true>(lds, g, S, E, wave);
        if (BOTH(3)) GRID_BAR(); }
    }
    if (IN(4)) {
        Gemm g{(const bf16*)(ws + WS_R + 640 * MiB), (const bf16*)(ws + WS_W_FGU), M, 2 * DFF, 1024, 0}; StaticOrder S; S.init(M, 2 * DFF, G, bx);
        EpiSwigluI<true, false> E{(void*)(ws + WS_R + R_HFF), DFF, 1.0f / (I8_SA_X1 * I8_SW), 1.f, (const u64*)(ws + WS_RSS1)};
        REPS(4) { gemm_phase<EpiSwigluI<true, false>, StaticOrder, true, true, false, true>(lds, g, S, E, wave);
        if (BOTH(4)) GRID_BAR(); }
    }
    if (IN(5)) {
        Gemm g{(const bf16*)(ws + WS_R + R_HFF), (const bf16*)(ws + WS_W_FD), M, 2048, DFF, 0}; StaticOrder S; S.init(M, 2048, G, bx);
        REPS(5) { EpiResidB16 E{xb, rep ? xb : (bf16*)(ws + WS_R + 608 * MiB), (u64*)(rep ? ws + WS_RSS2 : ws + WS_R + 736 * MiB), ws + WS_R + 640 * MiB, I8_SA_X2};
        gemm_phase<EpiResidB16, StaticOrder, true, true>(lds, g, S, E, wave);
        if (BOTH(5)) GRID_BAR(); }
    }
    if (IN(6)) {
        Gemm g{(const bf16*)(ws + WS_R + 640 * MiB), (const bf16*)(ws + WS_W_SIN), M, 4096, 1024, 0}; StaticOrder S; S.init(M, 4096, G, bx);
        REPS(6) { EpiSguIn E{(const u64*)(ws + WS_RSS2), (bf16*)(ws + WS_R + (rep ? R_U : 256 * MiB)), (bf16*)(ws + WS_R + (rep ? R_V : 384 * MiB)), (u64*)(rep ? ws + WS_LNST : ws + WS_R + 512 * MiB), 1.0f / (I8_SA_X2 * I8_SW)};
        gemm_phase<EpiSguIn, StaticOrder, true, true, false, true>(lds, g, S, E, wave);
        if (BOTH(6)) GRID_BAR(); }
    }
    if (IN(7)) {
        const Args args = ldargs();
        int last_g = -1; const int tid = TIDX();
        REPS(7) { SguPre cur, nxt; const int NU = (M / 128) * 16; pg8::f32x2 gg = {0.f, 0.f}, bb = {0.f, 0.f}; float bias0 = 0.f, bias1 = 0.f;
            if (bx < NU) sgu_load((const bf16*)(ws + WS_R + R_V), (const u64*)(ws + WS_LNST), bx >> 4, bx & 15, tid, cur);
            for (int u = bx; u < NU; u += G) { const int g = u & 15, bn = u >> 4;
            if (g != last_g) { sgu_load_wm(lds, args.in[14] + (size_t)g * 128 * 128, tid); last_g = g;
                gg = *(const pg8::f32x2*)(args.in[12] + 128 * g + 2 * (tid & 63)); bb = *(const pg8::f32x2*)(args.in[13] + 128 * g + 2 * (tid & 63));
                bias0 = args.in[15][g * 128 + 32 * (2 * ((tid >> 6) & 1)) + (tid & 31)]; bias1 = args.in[15][g * 128 + 32 * (2 * ((tid >> 6) & 1) + 1) + (tid & 31)]; }
            const int un = (u + G < NU) ? u + G : u;
            sgu_unit(lds, bn, g, (const bf16*)(ws + WS_R + R_U), (bf16*)(ws + WS_R + (rep ? R_U : 256 * MiB)), cur, (const bf16*)(ws + WS_R + R_V), (const u64*)(ws + WS_LNST), un >> 4, un & 15, nxt, gg, bb, bias0, bias1, tid);
            cur = nxt; }
        if (BOTH(7)) GRID_BAR(); }
    }
    if (IN(8)) {
        Gemm g{(const bf16*)(ws + WS_R + R_U), (const bf16*)(ws + WS_W_SOUT), M, 2048, 2048, 0}; StaticOrder S; S.init(M, 2048, G, bx);
        EpiResidB16 E{xb, xb, nullptr, nullptr, 0.f};
        REPS(8) { gemm_phase<EpiResidB16, StaticOrder, true, true>(lds, g, S, E, wave);
        if (BOTH(8)) GRID_BAR(); }
    }
    if (IN(9)) { const Args args = ldargs(); router_phase(args, lds, G, TIDX()); if (BOTH(9)) GRID_BAR(); }
    if (IN(10)) { const Args args = ldargs(); REPS(10) { assign_phase(args, (volatile LAS int*)(MISC + 16), (volatile LAS int*)(MISC + 48), vcu, G, TIDX()); if (BOTH(10)) GRID_BAR(); } }
    if (IN(11)) {
        const int np = __builtin_amdgcn_readfirstlane(((const int*)(ws + WS_NPAN))[0]);
        Gemm g{(const bf16*)(ws + WS_R + R_AS), (const bf16*)(ws + WS_W_MGU), np * 256, 2 * DFFE, 1024, (size_t)2 * DFFE * 2048};
        MoeOrder S; S.init(np, 2 * DFFE / 256, G, bx, (const int*)(ws + WS_PANE));
        EpiSwiglu8 E{ws + WS_R + R_H, DFFE, 1.0f / (F8_SA * F8_SW_UP), F8_SH};
        REPS(11) { gemm_phase<EpiSwiglu8, MoeOrder, true, true, true>(lds, g, S, E, wave);
        if (BOTH(11)) GRID_BAR(); }
    }
    if (IN(12)) {
        const int np = __builtin_amdgcn_readfirstlane(((const int*)(ws + WS_NPAN))[0]);
        Gemm g{(const bf16*)(ws + WS_R + R_H), (const bf16*)(ws + WS_W_MD), np * 256, 2048, DFFE / 2, (size_t)2048 * DFFE};
        MoeOrder S; S.init(np, 8, G, bx, (const int*)(ws + WS_PANE));
        EpiY E{(bf16*)(ws + WS_R + R_Y), (const int*)(ws + WS_ROWTOK), (const float*)(ws + WS_ROWW), 1.0f / (F8_SH * F8_SW_DN)};
        REPS(12) { gemm_phase<EpiY, MoeOrder, true, F8SP2, true>(lds, g, S, E, wave);
        if (BOTH(12) || (IN(12) && IN(15))) GRID_BAR(); }
    }
    if (IN(15)) {
        const Args args = ldargs();
        const float* fg = args.in[22]; const int gw = vcu * NWAVES + wave, NGW = G * NWAVES, lane = LANE();
        f32x4 gv[8];
#pragma unroll
        for (int j = 0; j < 4; ++j) { gv[2 * j] = ((const f32x4*)fg)[2 * lane + 128 * j]; gv[2 * j + 1] = ((const f32x4*)fg)[2 * lane + 1 + 128 * j]; }
        REPS(15) { float* dsto = rep ? out : (float*)(ws + WS_R + 272 * MiB);
        for (int m = gw; m < M; m += NGW) {
            const v4u* xr = (const v4u*)(xb + (size_t)m * D) + lane; f32x4* xw = (f32x4*)(dsto + (size_t)m * D) + 2 * lane; f32x4 v[8]; float s = 0.f;
            const v4u* y0 = (const v4u*)((const bf16*)(ws + WS_R + R_Y) + (size_t)m * D) + lane; const v4u* y1 = (const v4u*)((const bf16*)(ws + WS_R + R_Y) + (size_t)(M + m) * D) + lane;
#pragma unroll
            for (int j = 0; j < 4; ++j) { const v4u a0 = y0[64 * j], a1 = y1[64 * j], xq = xr[64 * j];
                v[2 * j] = (f32x4){bflo(xq.x) + (bflo(a0.x) + bflo(a1.x)), bfhi(xq.x) + (bfhi(a0.x) + bfhi(a1.x)), bflo(xq.y) + (bflo(a0.y) + bflo(a1.y)), bfhi(xq.y) + (bfhi(a0.y) + bfhi(a1.y))};
                v[2 * j + 1] = (f32x4){bflo(xq.z) + (bflo(a0.z) + bflo(a1.z)), bfhi(xq.z) + (bfhi(a0.z) + bfhi(a1.z)), bflo(xq.w) + (bflo(a0.w) + bflo(a1.w)), bfhi(xq.w) + (bfhi(a0.w) + bfhi(a1.w))};
                s += ((v[2 * j].x * v[2 * j].x + v[2 * j].y * v[2 * j].y) + (v[2 * j].z * v[2 * j].z + v[2 * j].w * v[2 * j].w)) + ((v[2 * j + 1].x * v[2 * j + 1].x + v[2 * j + 1].y * v[2 * j + 1].y) + (v[2 * j + 1].z * v[2 * j + 1].z + v[2 * j + 1].w * v[2 * j + 1].w)); }
            const float rs = 1.0f / sqrtf(wave_sum(s) * (1.0f / 2048.0f) + EPS);
#pragma unroll
            for (int j = 0; j < 4; ++j) { xw[128 * j] = v[2 * j] * rs * gv[2 * j]; xw[128 * j + 1] = v[2 * j + 1] * rs * gv[2 * j + 1]; }
        }
        if (rep == 0) GRID_BAR(); }
    }
#undef IN
#undef BOTH
}

extern "C" void kernel_launch(void* const* d_in, const int* in_sizes, int n_in, void* d_out, int out_size, void* d_ws, size_t ws_size, hipStream_t stream) {
    static int grid = 0;
    if (grid == 0) {
        if (n_in != 23 || in_sizes[0] != M * D || out_size != M * D || ws_size < WS_END) { fprintf(stderr, "kernel_launch: shape/workspace mismatch (n_in %d, in0 %d, out %d, ws %zu, need %zu)\n", n_in, n_in > 0 ? in_sizes[0] : -1, out_size, ws_size, (size_t)WS_END); grid = -1; return; }
        int dev = 0, cus = 0, per_cu = 0;
        if (hipGetDevice(&dev) != hipSuccess || hipDeviceGetAttribute(&cus, hipDeviceAttributeMultiprocessorCount, dev) != hipSuccess) { grid = -1; return; }
        if (hipFuncSetAttribute((const void*)trunk_fwd, hipFuncAttributeMaxDynamicSharedMemorySize, LDS_BYTES) != hipSuccess) { fprintf(stderr, "kernel_launch: hipFuncSetAttribute failed\n"); grid = -1; return; }
        if (hipOccupancyMaxActiveBlocksPerMultiprocessor(&per_cu, (const void*)trunk_fwd, NWAVES * 64, LDS_BYTES) != hipSuccess || per_cu < 1) fprintf(stderr, "kernel_launch: occupancy query reports %d\n", per_cu);
        (void)hipGetLastError();
        grid = cus;
    }
    if (grid < 0) return;
    if (hipMemsetAsync((char*)d_ws + WS_CTL, 0, CTL_ZERO_BYTES, stream) != hipSuccess) return;
    Args a{};
    for (int i = 0; i < 23; ++i) a.in[i] = (const float*)d_in[i];
    a.out = (float*)d_out; a.ws = (unsigned char*)d_ws;
#if MK_PER_PHASE
    for (int p = 0; p < NPH; ++p) { a.ph_lo = p; a.ph_hi = p + 1; hipLaunchKernelGGL(trunk_fwd, dim3(grid), dim3(NWAVES * 64), LDS_BYTES, stream, a); }
#else
    a.ph_lo = 0; a.ph_hi = NPH;
    hipLaunchKernelGGL(trunk_fwd, dim3(grid), dim3(NWAVES * 64), LDS_BYTES, stream, a);
#endif
}
```
